# Optimizing an MI355X kernel written in HIP

```python
import jax, jax.numpy as jnp
from jax import lax
import numpy as np

D_MODEL = 2048
BATCH = 1
SEQ = 8192
DEPTH = 4

D_MIX = D_MODEL
D_FF = 5632
NORM_EPS = 1e-6
BLOCK = 128

SB_HEADS = 4
SB_HEAD_DIM = 128
SB_WIDTH = SB_HEADS * SB_HEAD_DIM

MLA_HEADS = 4
MLA_NOPE_DIM = 128
MLA_ROPE_DIM = 64
MLA_V_DIM = 128
MLA_Q_LORA = 512
MLA_KV_LORA = 256
MLA_WIDTH = MLA_HEADS * MLA_V_DIM
ROPE_THETA = 10000.0

RWKV_HEADS = 16
RWKV_HEAD_DIM = 64
RWKV_WIDTH = RWKV_HEADS * RWKV_HEAD_DIM
RWKV_DECAY_LORA = 64
RWKV_A_LORA = 64
RWKV_GATE_LORA = 128
RWKV_GN_EPS = 64e-5

SB_COLS = 3 * SB_WIDTH
MLA_COLS = MLA_Q_LORA + MLA_KV_LORA + MLA_ROPE_DIM
RWKV_COLS = 3 * RWKV_WIDTH + RWKV_DECAY_LORA + RWKV_A_LORA + RWKV_GATE_LORA
IN_COLS = SB_COLS + MLA_COLS + RWKV_COLS

kernel_name = "hybrid_sb_mla_rwkv7_macaron"


def rmsnorm(x, g, eps=NORM_EPS):
    x32 = x.astype(jnp.float32)
    y = x32 * lax.rsqrt(jnp.mean(x32 * x32, axis=-1, keepdims=True) + eps)
    return (y * g.astype(jnp.float32)).astype(x.dtype)


def swiglu(h, w_gate, w_up, w_down):
    return (jax.nn.silu(h @ w_gate) * (h @ w_up)) @ w_down


def split_cols(z, sizes):
    idx = [int(i) for i in np.cumsum(sizes)[:-1]]
    return jnp.split(z, idx, axis=-1)


def to_blocks(t):
    b, s, h, d = t.shape
    return t.reshape(b, s // BLOCK, BLOCK, h, d).transpose(1, 0, 2, 3, 4)


def from_blocks(t):
    nb, b, blk, h, d = t.shape
    return t.transpose(1, 0, 2, 3, 4).reshape(b, nb * blk, h, d)


def stick_breaking_attention(q, k, v):
    s_len = q.shape[1]
    scale = SB_HEAD_DIM ** -0.5
    key_pos = jnp.arange(s_len)

    def block(args):
        q_blk, i = args
        z = jnp.einsum('bqhd,bkhd->bhqk', q_blk, k,
                       preferred_element_type=jnp.float32) * scale
        q_pos = i * BLOCK + jnp.arange(BLOCK)
        before = key_pos[None, :] < q_pos[:, None]
        log_beta = jax.nn.log_sigmoid(z)
        log_keep = jnp.where(before, jax.nn.log_sigmoid(-z), 0.0)
        later = lax.cumsum(log_keep, axis=3, reverse=True) - log_keep
        a = jnp.where(before, jnp.exp(log_beta + later), 0.0)
        return jnp.einsum('bhqk,bkhd->bqhd', a.astype(v.dtype), v)

    out = lax.map(block, (to_blocks(q), jnp.arange(s_len // BLOCK)))
    return from_blocks(out)


def apply_rope(t, cos, sin):
    t1, t2 = jnp.split(t.astype(jnp.float32), 2, axis=-1)
    return jnp.concatenate([t1 * cos - t2 * sin, t1 * sin + t2 * cos], axis=-1).astype(t.dtype)


def mla_attention(c_q, c_kv, k_rope, positions, q_norm, w_uq, kv_norm, w_ukv):
    b, s_len, _ = c_q.shape
    q = (rmsnorm(c_q, q_norm) @ w_uq).reshape(b, s_len, MLA_HEADS, MLA_NOPE_DIM + MLA_ROPE_DIM)
    q_nope, q_pe = jnp.split(q, [MLA_NOPE_DIM], axis=-1)
    kv = (rmsnorm(c_kv, kv_norm) @ w_ukv).reshape(b, s_len, MLA_HEADS, MLA_NOPE_DIM + MLA_V_DIM)
    k_nope, v = jnp.split(kv, [MLA_NOPE_DIM], axis=-1)

    half = MLA_ROPE_DIM // 2
    inv_freq = ROPE_THETA ** (-jnp.arange(half, dtype=jnp.float32) / half)
    ang = positions.astype(jnp.float32)[..., None] * inv_freq
    cos, sin = jnp.cos(ang), jnp.sin(ang)
    q_pe = apply_rope(q_pe, cos[:, :, None, :], sin[:, :, None, :])
    k_pe = apply_rope(k_rope, cos, sin)

    q = jnp.concatenate([q_nope, q_pe], axis=-1)
    k = jnp.concatenate(
        [k_nope, jnp.broadcast_to(k_pe[:, :, None, :], (b, s_len, MLA_HEADS, MLA_ROPE_DIM))], axis=-1)
    scale = (MLA_NOPE_DIM + MLA_ROPE_DIM) ** -0.5
    key_pos = jnp.arange(s_len)

    def block(args):
        q_blk, i = args
        sc = jnp.einsum('bqhd,bkhd->bhqk', q_blk, k,
                        preferred_element_type=jnp.float32) * scale
        q_pos = i * BLOCK + jnp.arange(BLOCK)
        sc = jnp.where(key_pos[None, :] <= q_pos[:, None], sc, jnp.finfo(jnp.float32).min)
        p = jax.nn.softmax(sc, axis=-1)
        return jnp.einsum('bhqk,bkhd->bqhd', p.astype(v.dtype), v)

    out = lax.map(block, (to_blocks(q), jnp.arange(s_len // BLOCK)))
    return from_blocks(out)


def rwkv7_time_mix(z, mu, w0, w2, a0, a2, g2, k_k, k_a, r_k, ln_w, ln_b):
    b, s_len, _ = z.shape
    f32 = jnp.float32
    z_prev = jnp.pad(z, ((0, 0), (1, 0), (0, 0)))[:, :-1]
    z = z + (z_prev - z) * mu
    r, k, v, xw, xa, xg = split_cols(
        z, [RWKV_WIDTH] * 3 + [RWKV_DECAY_LORA, RWKV_A_LORA, RWKV_GATE_LORA])

    log_w = -jax.nn.softplus(-(w0 + jnp.tanh(xw) @ w2)) - 0.5
    decay = jnp.exp(-jnp.exp(log_w.astype(f32)))
    a = jax.nn.sigmoid(a0 + xa @ a2)
    g = jax.nn.sigmoid(xg) @ g2

    def heads(t):
        return t.reshape(b, s_len, RWKV_HEADS, RWKV_HEAD_DIM).astype(f32)

    kk = heads(k * k_k)
    kk = kk / jnp.maximum(jnp.sqrt(jnp.sum(kk * kk, axis=-1, keepdims=True)), 1e-12)
    k = k * (1 + (a - 1) * k_a)
    r_h, k_h, v_h, a_h, w_h = heads(r), heads(k), heads(v), heads(a), heads(decay)

    def step(state, inp):
        r_t, w_t, k_t, v_t, kk_t, b_t = inp
        sa = jnp.einsum('bhvk,bhk->bhv', state, -kk_t)
        state = (state * w_t[:, :, None, :] + sa[..., None] * b_t[:, :, None, :]
                 + v_t[..., None] * k_t[:, :, None, :])
        return state, jnp.einsum('bhvk,bhk->bhv', state, r_t)

    xs = tuple(t.transpose(1, 0, 2, 3) for t in (r_h, w_h, k_h, v_h, kk, kk * a_h))
    s0 = jnp.zeros((b, RWKV_HEADS, RWKV_HEAD_DIM, RWKV_HEAD_DIM), f32)
    _, y = lax.scan(step, s0, xs)
    y = y.transpose(1, 0, 2, 3)

    mean = jnp.mean(y, axis=-1, keepdims=True)
    var = jnp.mean(jnp.square(y - mean), axis=-1, keepdims=True)
    y = (y - mean) * lax.rsqrt(var + RWKV_GN_EPS)
    y = (y * ln_w.astype(f32).reshape(RWKV_HEADS, RWKV_HEAD_DIM)
         + ln_b.astype(f32).reshape(RWKV_HEADS, RWKV_HEAD_DIM))
    y = y + jnp.sum(r_h * k_h * r_k.astype(f32), axis=-1, keepdims=True) * v_h
    return (y.reshape(b, s_len, RWKV_WIDTH) * g).astype(z.dtype)


def setup_inputs(seed: int = 0) -> dict:
    key = jax.random.key(seed)
    ks = iter(jax.random.split(key, 40))
    f32 = jnp.float32
    L = DEPTH

    def normal(shape, scale):
        return jax.random.normal(next(ks), shape, f32) * scale

    def gain(shape):
        return 1.0 + normal(shape, 0.02)

    ratio = jnp.arange(RWKV_WIDTH, dtype=f32) / (RWKV_WIDTH - 1)
    inputs = {
        "x": normal((BATCH, SEQ, D_MODEL), 1.0),
        "positions": jnp.broadcast_to(jnp.arange(SEQ, dtype=jnp.int32)[None, :], (BATCH, SEQ)),
        "ffn1_norm": gain((L, D_MODEL)),
        "ffn1_gate": normal((L, D_MODEL, D_FF), D_MODEL ** -0.5),
        "ffn1_up": normal((L, D_MODEL, D_FF), D_MODEL ** -0.5),
        "ffn1_down": normal((L, D_FF, D_MODEL), D_FF ** -0.5),
        "mix_norm": gain((L, D_MODEL)),
        "w_in": normal((L, D_MODEL, IN_COLS), D_MODEL ** -0.5),
        "mla_q_norm": gain((L, MLA_Q_LORA)),
        "mla_w_uq": normal((L, MLA_Q_LORA, MLA_HEADS * (MLA_NOPE_DIM + MLA_ROPE_DIM)), MLA_Q_LORA ** -0.5),
        "mla_kv_norm": gain((L, MLA_KV_LORA)),
        "mla_w_ukv": normal((L, MLA_KV_LORA, MLA_HEADS * (MLA_NOPE_DIM + MLA_V_DIM)), MLA_KV_LORA ** -0.5),
        "rwkv_mu": jax.random.uniform(next(ks), (L, RWKV_COLS), f32, 0.1, 0.9),
        "rwkv_w0": -6.0 + 5.0 * ratio ** 0.85 + normal((L, RWKV_WIDTH), 0.1),
        "rwkv_w2": normal((L, RWKV_DECAY_LORA, RWKV_WIDTH), 0.5 * RWKV_DECAY_LORA ** -0.5),
        "rwkv_a0": normal((L, RWKV_WIDTH), 0.1),
        "rwkv_a2": normal((L, RWKV_A_LORA, RWKV_WIDTH), 0.5 * RWKV_A_LORA ** -0.5),
        "rwkv_g2": normal((L, RWKV_GATE_LORA, RWKV_WIDTH), RWKV_GATE_LORA ** -0.5),
        "rwkv_k_k": 0.85 + normal((L, RWKV_WIDTH), 0.02),
        "rwkv_k_a": gain((L, RWKV_WIDTH)),
        "rwkv_r_k": normal((L, RWKV_HEADS, RWKV_HEAD_DIM), 0.1),
        "rwkv_ln_w": gain((L, RWKV_WIDTH)),
        "rwkv_ln_b": normal((L, RWKV_WIDTH), 0.02),
        "sb_out_norm": gain((L, SB_HEADS, SB_HEAD_DIM)),
        "mla_out_norm": gain((L, MLA_HEADS, MLA_V_DIM)),
        "w_out": normal((L, D_MIX, D_MODEL), D_MIX ** -0.5),
        "ffn2_norm": gain((L, D_MODEL)),
        "ffn2_gate": normal((L, D_MODEL, D_FF), D_MODEL ** -0.5),
        "ffn2_up": normal((L, D_MODEL, D_FF), D_MODEL ** -0.5),
        "ffn2_down": normal((L, D_FF, D_MODEL), D_FF ** -0.5),
        "final_norm": gain((D_MODEL,)),
    }
    return inputs


def reference(x, positions, ffn1_norm, ffn1_gate, ffn1_up, ffn1_down, mix_norm, w_in,
              mla_q_norm, mla_w_uq, mla_kv_norm, mla_w_ukv,
              rwkv_mu, rwkv_w0, rwkv_w2, rwkv_a0, rwkv_a2, rwkv_g2, rwkv_k_k, rwkv_k_a,
              rwkv_r_k, rwkv_ln_w, rwkv_ln_b, sb_out_norm, mla_out_norm, w_out,
              ffn2_norm, ffn2_gate, ffn2_up, ffn2_down, final_norm):
    b, s_len, _ = x.shape
    for l in range(DEPTH):
        x = x + 0.5 * swiglu(rmsnorm(x, ffn1_norm[l]), ffn1_gate[l], ffn1_up[l], ffn1_down[l])

        h = rmsnorm(x, mix_norm[l])
        z = h @ w_in[l]
        sb_q, sb_k, sb_v, c_q, c_kv, k_rope, z_rwkv = split_cols(
            z, [SB_WIDTH] * 3 + [MLA_Q_LORA, MLA_KV_LORA, MLA_ROPE_DIM, RWKV_COLS])

        sb_shape = (b, s_len, SB_HEADS, SB_HEAD_DIM)
        y_sb = stick_breaking_attention(sb_q.reshape(sb_shape), sb_k.reshape(sb_shape),
                                        sb_v.reshape(sb_shape))
        y_sb = rmsnorm(y_sb, sb_out_norm[l]).reshape(b, s_len, SB_WIDTH)

        y_mla = mla_attention(c_q, c_kv, k_rope, positions, mla_q_norm[l], mla_w_uq[l],
                              mla_kv_norm[l], mla_w_ukv[l])
        y_mla = rmsnorm(y_mla, mla_out_norm[l]).reshape(b, s_len, MLA_WIDTH)

        y_rwkv = rwkv7_time_mix(z_rwkv, rwkv_mu[l], rwkv_w0[l], rwkv_w2[l], rwkv_a0[l],
                                rwkv_a2[l], rwkv_g2[l], rwkv_k_k[l], rwkv_k_a[l],
                                rwkv_r_k[l], rwkv_ln_w[l], rwkv_ln_b[l])

        x = x + jnp.concatenate([y_sb, y_mla, y_rwkv], axis=-1) @ w_out[l]

        x = x + 0.5 * swiglu(rmsnorm(x, ffn2_norm[l]), ffn2_gate[l], ffn2_up[l], ffn2_down[l])
    return rmsnorm(x, final_norm)
```

```cpp
#include <hip/hip_runtime.h>
#include <cstdio>
#include <cstdint>
#define LAS __attribute__((address_space(3)))
#define GAS __attribute__((address_space(1)))

#define MK_SINGLE 1
namespace pg8 {
#define PG8_LAS __attribute__((address_space(3)))
typedef unsigned short bf16_t;
typedef short bf16x8 __attribute__((ext_vector_type(8)));
typedef float f32x4 __attribute__((ext_vector_type(4)));
typedef unsigned u32x4 __attribute__((ext_vector_type(4)));
constexpr int BM = 256, BK = 64, HALF = 128, HTB = HALF * BK * 2  , STAGE_BYTES = 8 * HTB, NXCD = 8, WGM = 8;

__host__ __device__ __forceinline__ int lds_byte(int r, int c) { const int st = (r >> 4) * 2 + (c >> 5), rr = r & 15, cc = c & 31, ob = rr * 64 + cc * 2; return st * 1024 + (ob ^ (((ob >> 9) & 1) << 5)); }
__host__ __device__ __forceinline__ void stage_rc(int b, int& R, int& C) { const int st = b / 1024, sb = b % 1024, swz = sb ^ (((sb >> 9) & 1) << 5); R = (st >> 1) * 16 + swz / 64; C = (st & 1) * 32 + (swz % 64) / 2; }
__host__ __device__ __forceinline__ int perm32(int rho) { const int n = rho >> 4, i = rho & 15; return 8 * (i >> 2) + 4 * n + (i & 3); }

struct Unit { int pm, pn; };
struct Gemm { const bf16_t* A; const bf16_t* Bt; int M, N, K; };

struct StaticOrder {
    int nM, nN, nwg, G, c;
    __host__ __device__ void init(int M, int N, int G_, int c_) { nM = M / BM; nN = N / BM; nwg = nM * nN; G = G_; c = c_; }
    __host__ __device__ bool next(int i, Unit& u) const {
        const long L = (long)i * G + c; if (L >= nwg) return false;
        int wgid = (int)L; { const int q = nwg / NXCD, r = nwg % NXCD, xcd = wgid % NXCD, off = wgid / NXCD; wgid = (xcd < r ? xcd * (q + 1) : r * (q + 1) + (xcd - r) * q) + off; }
        const int nig = WGM * nN, gid = wgid / nig, fm = gid * WGM, gsz = (nM - fm) < WGM ? (nM - fm) : WGM;
        u.pm = fm + ((wgid % nig) % gsz); u.pn = (wgid % nig) / gsz; return true;
    }
    __device__ __forceinline__ void a_ready(const Unit&) const {}
    __device__ __forceinline__ void done(const Unit&) const {}
};

template <class Epi, class Sched, bool ALIGN_EPI = false, bool SP2 = false>
__device__ __forceinline__ void gemm_phase(PG8_LAS unsigned char* lds, const Gemm g, const Sched& S, const Epi& E, int tid_in) {
    int tid_o = tid_in; asm volatile("" : "+v"(tid_o));
    const int tid = tid_o, wid = __builtin_amdgcn_readfirstlane(tid >> 6), lane = tid & 63, wr = wid >> 2, wc = wid & 3, fr = lane & 15, fq = lane >> 4;
    const int K = g.K, nt = K / BK;
    unsigned voffA[2], voffB[2];
#pragma unroll
    for (int i = 0; i < 2; ++i) { int R, C; stage_rc(tid * 16 + i * 8192, R, C); const int Rb = Epi::PERM ? ((R & ~31) + perm32(R & 31)) : R;
        voffA[i] = (unsigned)(R * K + C) * 2u; voffB[i] = (unsigned)(Rb * K + C) * 2u; }
    const size_t kstep = (size_t)(BK * 2);
    const size_t hstep = (size_t)HALF * K * 2;
    const size_t tstep = 2 * hstep;
    const unsigned ldsw = (unsigned)wid * 1024u;
    const int aoff = lds_byte(wr * 64 + fr, fq * 8), boff = lds_byte(wc * 32 + fr, fq * 8);
#define PG8_SA(b, h) (((b) * 2 + (h)) * HTB)
#define PG8_SB(b, h) ((4 + (b) * 2 + (h)) * HTB)
#define PG8_STAGE(bufoff, gbase, voff) do { _Pragma("unroll") for (int _i = 0; _i < 2; ++_i) \
        __builtin_amdgcn_global_load_lds((const unsigned*)((const char*)(gbase) + (voff)[_i]), (PG8_LAS unsigned*)(lds + (bufoff) + ldsw + _i * 8192), 16, 0, 0); } while (0)
#define PG8_LDA(dst, b, h) do { _Pragma("unroll") for (int m = 0; m < 4; ++m) _Pragma("unroll") for (int k = 0; k < 2; ++k) dst[m][k] = *(const PG8_LAS bf16x8*)(lds + PG8_SA(b, h) + aoff + m * 2048 + k * 1024); } while (0)
#define PG8_LDB(dst, b, h) do { _Pragma("unroll") for (int n = 0; n < 2; ++n) _Pragma("unroll") for (int k = 0; k < 2; ++k) dst[n][k] = *(const PG8_LAS bf16x8*)(lds + PG8_SB(b, h) + boff + n * 2048 + k * 1024); } while (0)
#define PG8_MMA(ai, bj, At, Bt) do { __builtin_amdgcn_s_setprio(1); _Pragma("unroll") for (int m = 0; m < 4; ++m) _Pragma("unroll") for (int n = 0; n < 2; ++n) _Pragma("unroll") for (int k = 0; k < 2; ++k) \
        acc[ai][bj][m][n] = __builtin_amdgcn_mfma_f32_16x16x32_bf16(Bt[n][k], At[m][k], acc[ai][bj][m][n], 0, 0, 0); __builtin_amdgcn_s_setprio(0); } while (0)
#define PG8_WAIT_V(n) asm volatile("s_waitcnt vmcnt(" #n ")" ::: "memory")
#define PG8_WAIT_L(n) asm volatile("s_waitcnt lgkmcnt(" #n ")" ::: "memory")
#define PG8_BAR __builtin_amdgcn_s_barrier()
#define PG8_SCHED __builtin_amdgcn_sched_barrier(0)
    Unit cur, nxt; int ui = 0;
    if (!S.next(0, cur)) return;
    f32x4 acc[2][2][4][2];
#pragma unroll
    for (int a = 0; a < 2; ++a)
#pragma unroll
        for (int b = 0; b < 2; ++b)
#pragma unroll
            for (int m = 0; m < 4; ++m)
#pragma unroll
                for (int n = 0; n < 2; ++n) acc[a][b][m][n] = (f32x4){0.f, 0.f, 0.f, 0.f};
    bf16x8 At[4][2], B0[2][2], B1[2][2];
    const char* cA = (const char*)g.A + (size_t)cur.pm * tstep; const char* cB = (const char*)g.Bt + (size_t)cur.pn * tstep;
    S.a_ready(cur);
    if constexpr (SP2) {
        PG8_STAGE(PG8_SB(0, 0), cB, voffB); PG8_STAGE(PG8_SB(0, 1), cB + hstep, voffB); PG8_STAGE(PG8_SA(0, 0), cA, voffA); PG8_STAGE(PG8_SA(0, 1), cA + hstep, voffA);
        if (wr == 1) PG8_BAR;
        PG8_WAIT_V(2); PG8_BAR;
        PG8_STAGE(PG8_SB(1, 0), cB + kstep, voffB); PG8_STAGE(PG8_SA(1, 0), cA + kstep, voffA); PG8_STAGE(PG8_SB(1, 1), cB + hstep + kstep, voffB);
        PG8_WAIT_V(6); PG8_BAR;
    } else {
        PG8_STAGE(PG8_SB(0, 0), cB, voffB); PG8_STAGE(PG8_SA(0, 0), cA, voffA); PG8_STAGE(PG8_SB(0, 1), cB + hstep, voffB); PG8_STAGE(PG8_SA(0, 1), cA + hstep, voffA);
        if (wr == 1) PG8_BAR;
        PG8_WAIT_V(4); PG8_BAR;
        PG8_STAGE(PG8_SB(1, 0), cB + kstep, voffB); PG8_STAGE(PG8_SA(1, 0), cA + kstep, voffA); PG8_STAGE(PG8_SB(1, 1), cB + hstep + kstep, voffB);
        PG8_WAIT_V(6); PG8_BAR;
    }
    for (;;) {
        const bool has_next = S.next(ui + 1, nxt);
        const char* nA = has_next ? (const char*)g.A + (size_t)nxt.pm * tstep : cA; const char* nB = has_next ? (const char*)g.Bt + (size_t)nxt.pn * tstep : cB;
        for (int t = 0; t < nt; t += 2) {
            const bool last = (t == nt - 2);
            const char* a1 = cA + (size_t)(t + 1) * kstep;
            const char* a2 = last ? nA : cA + (size_t)(t + 2) * kstep; const char* b2 = last ? nB : cB + (size_t)(t + 2) * kstep;
            const char* a3 = a2 + kstep; const char* b3 = b2 + kstep;
            if (last && has_next) S.a_ready(nxt);
            if constexpr (SP2) {
            PG8_LDB(B0, 0, 0); PG8_LDB(B1, 0, 1); PG8_SCHED; PG8_LDA(At, 0, 0); PG8_STAGE(PG8_SA(1, 1), a1 + hstep, voffA);
            PG8_WAIT_V(8); PG8_WAIT_L(0); PG8_BAR; PG8_MMA(0, 0, At, B0); PG8_MMA(0, 1, At, B1); PG8_BAR; PG8_SCHED;
            PG8_LDA(At, 0, 1); PG8_STAGE(PG8_SB(0, 0), b2, voffB); PG8_STAGE(PG8_SB(0, 1), b2 + hstep, voffB); PG8_STAGE(PG8_SA(0, 0), a2, voffA);
            PG8_WAIT_V(8); PG8_WAIT_L(0); PG8_BAR; PG8_MMA(1, 0, At, B0); PG8_MMA(1, 1, At, B1); PG8_BAR; PG8_SCHED;
            PG8_LDB(B0, 1, 0); PG8_LDB(B1, 1, 1); PG8_SCHED; PG8_LDA(At, 1, 0); PG8_STAGE(PG8_SA(0, 1), a2 + hstep, voffA);
            PG8_WAIT_V(8); PG8_WAIT_L(0); PG8_BAR; PG8_MMA(0, 0, At, B0); PG8_MMA(0, 1, At, B1); PG8_BAR; PG8_SCHED;
            PG8_LDA(At, 1, 1); PG8_STAGE(PG8_SB(1, 0), b3, voffB); PG8_STAGE(PG8_SB(1, 1), b3 + hstep, voffB); PG8_STAGE(PG8_SA(1, 0), a3, voffA);
            PG8_WAIT_V(8); PG8_WAIT_L(0); PG8_BAR; PG8_MMA(1, 0, At, B0); PG8_MMA(1, 1, At, B1); PG8_BAR; PG8_SCHED;
            } else {
            PG8_LDB(B0, 0, 0); PG8_SCHED; PG8_LDA(At, 0, 0); PG8_STAGE(PG8_SA(1, 1), a1 + hstep, voffA);
            PG8_WAIT_L(8); PG8_BAR; PG8_WAIT_L(0); PG8_MMA(0, 0, At, B0); PG8_BAR; PG8_SCHED;
            PG8_LDB(B1, 0, 1); PG8_STAGE(PG8_SB(0, 0), b2, voffB);
            PG8_BAR; PG8_WAIT_L(0); PG8_MMA(0, 1, At, B1); PG8_BAR;
            PG8_LDA(At, 0, 1); PG8_STAGE(PG8_SA(0, 0), a2, voffA);
            PG8_BAR; PG8_WAIT_L(0); PG8_MMA(1, 0, At, B0); PG8_BAR; PG8_SCHED;
            PG8_STAGE(PG8_SB(0, 1), b2 + hstep, voffB);
            PG8_WAIT_V(6); PG8_BAR; PG8_MMA(1, 1, At, B1); PG8_BAR;
            PG8_LDB(B0, 1, 0); PG8_SCHED; PG8_LDA(At, 1, 0); PG8_STAGE(PG8_SA(0, 1), a2 + hstep, voffA);
            PG8_WAIT_L(8); PG8_BAR; PG8_WAIT_L(0); PG8_MMA(0, 0, At, B0); PG8_BAR; PG8_SCHED;
            PG8_LDB(B1, 1, 1); PG8_STAGE(PG8_SB(1, 0), b3, voffB);
            PG8_BAR; PG8_WAIT_L(0); PG8_MMA(0, 1, At, B1); PG8_BAR;
            PG8_LDA(At, 1, 1); PG8_STAGE(PG8_SA(1, 0), a3, voffA);
            PG8_BAR; PG8_WAIT_L(0); PG8_MMA(1, 0, At, B0); PG8_BAR; PG8_SCHED;
            PG8_STAGE(PG8_SB(1, 1), b3 + hstep, voffB);
            PG8_WAIT_V(6); PG8_BAR; PG8_MMA(1, 1, At, B1); PG8_BAR;
            }
        }
        if constexpr (ALIGN_EPI) { if (wr == 0) PG8_BAR; }
        if constexpr (!Epi::AFTER_DRAIN) {
            int le_; asm volatile("v_mbcnt_lo_u32_b32 %0, -1, 0\n\tv_mbcnt_hi_u32_b32 %0, -1, %0" : "=v"(le_));
            E(acc, cur, wr, wc, le_ & 15, le_ >> 4); S.done(cur); }
        if (!has_next) break;
#pragma unroll
        for (int a = 0; a < 2; ++a)
#pragma unroll
            for (int b = 0; b < 2; ++b)
#pragma unroll
                for (int m = 0; m < 4; ++m)
#pragma unroll
                    for (int n = 0; n < 2; ++n) acc[a][b][m][n] = (f32x4){0.f, 0.f, 0.f, 0.f};
        cur = nxt; cA = nA; cB = nB; ++ui;
        if constexpr (ALIGN_EPI) { if (wr == 1) PG8_BAR; }
    }
    PG8_WAIT_V(0);
    if constexpr (!ALIGN_EPI) { if (wr == 0) PG8_BAR; }
    PG8_BAR;
    if constexpr (Epi::AFTER_DRAIN) { E.fused(acc, cur, wr, wc, fr, fq, lds, wid, lane); S.done(cur); }
#undef PG8_SA
#undef PG8_SB
#undef PG8_STAGE
#undef PG8_LDA
#undef PG8_LDB
#undef PG8_MMA
#undef PG8_WAIT_V
#undef PG8_WAIT_L
#undef PG8_BAR
#undef PG8_SCHED
}
}
#define XB_TMO      128
#define XB_XCNT(j)  (256  + 64 * (j))
#define XB_XSUB(j)  (1280 + 64 * (j))
#define XB_XGEN(j)  (2304 + 64 * (j))
#define XB_TOP      3328
#define XB_TOPGEN   3392
#define XCD_BAR_WORDS 3456
#define XB_SPIN_CAP (1u << 22)

__device__ __forceinline__ unsigned xb_ld(unsigned* p)              { return __hip_atomic_load(p, __ATOMIC_RELAXED, __HIP_MEMORY_SCOPE_AGENT); }
__device__ __forceinline__ unsigned xb_add(unsigned* p, unsigned v) { return __hip_atomic_fetch_add(p, v, __ATOMIC_RELAXED, __HIP_MEMORY_SCOPE_AGENT); }
__device__ __forceinline__ unsigned xb_xcc_id() { return (unsigned)__builtin_amdgcn_s_getreg((3 << 11) | 20) & 0xFu; }
#define XB_SPIN(cond, bar) do { unsigned _sp = 0; while (cond) { __builtin_amdgcn_s_sleep(1); \
    if ((++_sp & 255u) == 0u) { if (xb_ld(&(bar)[XB_TMO])) break; if (_sp > XB_SPIN_CAP) { atomicAdd(&(bar)[XB_TMO], 1u); break; } } } } while (0)

struct XcdBarrier {
    unsigned* bar; unsigned x;
    volatile LAS unsigned* st;
};

__device__ __forceinline__ XcdBarrier xcd_barrier_post(unsigned* bar, volatile LAS unsigned* st) {
    XcdBarrier b; b.bar = bar; b.x = xb_xcc_id(); b.st = st;
    if (threadIdx.x == 0) (void)xb_add(&bar[XB_XCNT(b.x)], 1u);
    return b;
}
__device__ __forceinline__ void xcd_barrier_complete(unsigned* bar, unsigned x, unsigned& nloc, unsigned& nx) {
    const unsigned G = gridDim.x * gridDim.y * gridDim.z;
    unsigned sum, cnt, mine, sp = 0u;
    for (;;) {
        sum = 0u; cnt = 0u; mine = 0u;
#pragma unroll
        for (unsigned j = 0; j < 16; ++j) { const unsigned c = xb_ld(&bar[XB_XCNT(j)]); sum += c; cnt += (c > 0u) ? 1u : 0u; mine = (j == x) ? c : mine; }
        if (sum == G) break;
        __builtin_amdgcn_s_sleep(1);
        if ((++sp & 255u) == 0u) { if (xb_ld(&bar[XB_TMO])) break; if (sp > XB_SPIN_CAP) { atomicAdd(&bar[XB_TMO], 1u); break; } }
    }
    nloc = mine > 0u ? mine : 1u; nx = cnt > 0u ? cnt : 1u;
}

__device__ __forceinline__ void xcd_barrier(const XcdBarrier& b, int tid_in) {
    asm volatile("s_waitcnt vmcnt(0)" ::: "memory");
    __syncthreads();
    if (tid_in == 0) {
        unsigned* bar = b.bar;
        __builtin_amdgcn_s_waitcnt(0);
        unsigned nloc = b.st[0], nx = b.st[1];
        if (nloc == 0u) { xcd_barrier_complete(bar, b.x, nloc, nx); b.st[0] = nloc; b.st[1] = nx; }
        const unsigned old = xb_add(&bar[XB_XSUB(b.x)], 1u);
        const unsigned gen = old / nloc;
        if (old + 1u == (gen + 1u) * nloc) {
            __builtin_amdgcn_fence(__ATOMIC_RELEASE, "agent");
            asm volatile("s_waitcnt vmcnt(0)" ::: "memory");
            const unsigned og = xb_add(&bar[XB_TOP], 1u);
            const unsigned tg = og / nx;
            if (og + 1u == (tg + 1u) * nx) xb_add(&bar[XB_TOPGEN], 1u);
            else XB_SPIN(xb_ld(&bar[XB_TOPGEN]) == tg, bar);
            __builtin_amdgcn_fence(__ATOMIC_ACQUIRE, "agent");
            xb_add(&bar[XB_XGEN(b.x)], 1u);
            asm volatile("s_waitcnt vmcnt(0)" ::: "memory");
        } else {
            XB_SPIN(xb_ld(&bar[XB_XGEN(b.x)]) == gen, bar);
            __builtin_amdgcn_fence(__ATOMIC_ACQUIRE, "agent");
            asm volatile("s_waitcnt vmcnt(0)" ::: "memory");
        }
    }
    __syncthreads();
}

namespace pg8 {
typedef float f32x2_t __attribute__((ext_vector_type(2)));
typedef __bf16 bf16x2_t __attribute__((ext_vector_type(2)));
__device__ __forceinline__ unsigned pk_bf16(float lo, float hi) { const f32x2_t v = {lo, hi}; const bf16x2_t b = __builtin_convertvector(v, bf16x2_t); return __builtin_bit_cast(unsigned, b); }
#define DI_PG8 __device__ __forceinline__
__device__ __forceinline__ float silu_f(float g) { return g * __builtin_amdgcn_rcpf(1.f + __expf(-g)); }
DI_PG8 float row_rstd(const float* part, int row) {
    const f32x4* pp = (const f32x4*)(part + (size_t)row * 8); const f32x4 p0 = pp[0], p1 = pp[1];
    return 1.f / sqrtf((((p0.x + p0.y) + (p0.z + p0.w)) + ((p1.x + p1.y) + (p1.z + p1.w))) * (1.f / 2048.f) + 1e-6f);
}
struct EpiSwiglu {
    static constexpr bool PERM = true, AFTER_DRAIN = false;
    bf16_t* H; int ldh; const PG8_LAS _Float16* rt;
    __device__ __forceinline__ void operator()(const f32x4 (&acc)[2][2][4][2], const Unit& u, int wr, int wc, int fr, int fq) const {
        const int row0 = u.pm * BM + wr * 64 + fr, col0 = u.pn * HALF + wc * 32 + 8 * fq;
#pragma unroll
        for (int ai = 0; ai < 2; ++ai)
#pragma unroll
            for (int m = 0; m < 4; ++m) {
                bf16_t* p = H + (size_t)(row0 + ai * HALF + m * 16) * ldh + col0;
                const float rs = (float)rt[row0 + ai * HALF + m * 16];
                const f32x4 g0 = acc[ai][0][m][0] * rs, g1 = acc[ai][0][m][1] * rs, u0 = acc[ai][1][m][0] * rs, u1 = acc[ai][1][m][1] * rs;
                u32x4 w;
                w.x = pk_bf16(silu_f(g0[0]) * u0[0], silu_f(g0[1]) * u0[1]); w.y = pk_bf16(silu_f(g0[2]) * u0[2], silu_f(g0[3]) * u0[3]);
                w.z = pk_bf16(silu_f(g1[0]) * u1[0], silu_f(g1[1]) * u1[1]); w.w = pk_bf16(silu_f(g1[2]) * u1[2], silu_f(g1[3]) * u1[3]);
                *(u32x4*)p = w;
            }
    }
};
struct EpiResid {
    static constexpr bool PERM = true, AFTER_DRAIN = false;
    bf16_t* X; int ldx; float scale; float* part; PG8_LAS float* lp;
    __device__ __forceinline__ void operator()(const f32x4 (&acc)[2][2][4][2], const Unit& u, int wr, int wc, int fr, int fq) const {
        const int row0 = u.pm * BM + wr * 64 + fr, col0 = u.pn * BM + wc * 32 + 8 * fq;
#pragma unroll
        for (int ai = 0; ai < 2; ++ai)
#pragma unroll
            for (int m = 0; m < 4; ++m) {
                float ss = 0.f;
#pragma unroll
                for (int bj = 0; bj < 2; ++bj) {
                    bf16_t* p = X + (size_t)(row0 + ai * HALF + m * 16) * ldx + col0 + bj * HALF;
                    const u32x4 w = *(const u32x4*)p;
                    const f32x4 a = acc[ai][bj][m][0] * scale, b = acc[ai][bj][m][1] * scale;
                    u32x4 o;
                    o.x = pk_bf16(__uint_as_float(w.x << 16) + a.x, __uint_as_float(w.x & 0xffff0000u) + a.y); o.y = pk_bf16(__uint_as_float(w.y << 16) + a.z, __uint_as_float(w.y & 0xffff0000u) + a.w);
                    o.z = pk_bf16(__uint_as_float(w.z << 16) + b.x, __uint_as_float(w.z & 0xffff0000u) + b.y); o.w = pk_bf16(__uint_as_float(w.w << 16) + b.z, __uint_as_float(w.w & 0xffff0000u) + b.w);
                    *(u32x4*)p = o;
                    const float e0 = __uint_as_float(o.x << 16), e1 = __uint_as_float(o.x & 0xffff0000u), e2 = __uint_as_float(o.y << 16), e3 = __uint_as_float(o.y & 0xffff0000u);
                    const float e4 = __uint_as_float(o.z << 16), e5 = __uint_as_float(o.z & 0xffff0000u), e6 = __uint_as_float(o.w << 16), e7 = __uint_as_float(o.w & 0xffff0000u);
                    ss += ((e0 * e0 + e1 * e1) + (e2 * e2 + e3 * e3)) + ((e4 * e4 + e5 * e5) + (e6 * e6 + e7 * e7));
                }
                { auto r1 = __builtin_amdgcn_permlane16_swap(__float_as_uint(ss), __float_as_uint(ss), false, false); ss = __uint_as_float(r1[0]) + __uint_as_float(r1[1]); }
                { auto r2 = __builtin_amdgcn_permlane32_swap(__float_as_uint(ss), __float_as_uint(ss), false, false); ss = __uint_as_float(r2[0]) + __uint_as_float(r2[1]); }
                if (fq == 0) lp[wc * 256 + ai * HALF + wr * 64 + m * 16 + fr] = ss;
            }
        asm volatile("s_waitcnt lgkmcnt(0)" ::: "memory"); __builtin_amdgcn_s_barrier(); asm volatile("" ::: "memory");
        if (wr == 0) { const int rl = wc * 64 + fq * 16 + fr;
            part[(size_t)(u.pm * BM + rl) * 8 + u.pn] = (lp[rl] + lp[256 + rl]) + (lp[512 + rl] + lp[768 + rl]); }
    }
};
struct EpiF32 {
    static constexpr bool PERM = true, AFTER_DRAIN = false;
    float* C; int ldc;
    __device__ __forceinline__ void operator()(const f32x4 (&acc)[2][2][4][2], const Unit& u, int wr, int wc, int fr, int fq) const {
        const int row0 = u.pm * BM + wr * 64 + fr, col0 = u.pn * BM + wc * 32 + 8 * fq;
#pragma unroll
        for (int ai = 0; ai < 2; ++ai)
#pragma unroll
            for (int m = 0; m < 4; ++m)
#pragma unroll
                for (int bj = 0; bj < 2; ++bj) {
                    float* p = C + (size_t)(row0 + ai * HALF + m * 16) * ldc + col0 + bj * HALF;
                    *(f32x4*)p = acc[ai][bj][m][0]; *(f32x4*)(p + 4) = acc[ai][bj][m][1];
                }
    }
};
struct EpiBf16 {
    static constexpr bool PERM = true, AFTER_DRAIN = false;
    bf16_t* C; int ldc; const PG8_LAS _Float16* rt;
    __device__ __forceinline__ void operator()(const f32x4 (&acc)[2][2][4][2], const Unit& u, int wr, int wc, int fr, int fq) const {
        const int row0 = u.pm * BM + wr * 64 + fr, col0 = u.pn * BM + wc * 32 + 8 * fq;
#pragma unroll
        for (int ai = 0; ai < 2; ++ai)
#pragma unroll
            for (int m = 0; m < 4; ++m) {
                const float rs = rt ? (float)rt[row0 + ai * HALF + m * 16] : 1.f;
#pragma unroll
                for (int bj = 0; bj < 2; ++bj) {
                    const f32x4 v0 = acc[ai][bj][m][0] * rs, v1 = acc[ai][bj][m][1] * rs;
                    u32x4 w; w.x = pk_bf16(v0[0], v0[1]); w.y = pk_bf16(v0[2], v0[3]); w.z = pk_bf16(v1[0], v1[1]); w.w = pk_bf16(v1[2], v1[3]);
                    *(u32x4*)(C + (size_t)(row0 + ai * HALF + m * 16) * ldc + col0 + bj * HALF) = w;
                } }
    }
};
struct EpiVT {
    static constexpr bool PERM = true, AFTER_DRAIN = false;
    bf16_t* C; int ldc;
    __device__ __forceinline__ void operator()(const f32x4 (&acc)[2][2][4][2], const Unit& u, int wr, int wc, int fr, int fq) const {
        const int row0 = u.pm * BM + wr * 64 + fr, col0 = u.pn * BM + wc * 32 + 8 * fq, g = fq & 1;
#pragma unroll
        for (int ai = 0; ai < 2; ++ai)
#pragma unroll
            for (int m = 0; m < 4; ++m)
#pragma unroll
                for (int bj = 0; bj < 2; ++bj) {
                    bf16_t* p = C + (size_t)(row0 + ai * HALF + m * 16) * ldc + ((col0 + bj * HALF) & ~15);
                    const f32x4 v0 = acc[ai][bj][m][0], v1 = acc[ai][bj][m][1];
                    typedef unsigned u32x2_ __attribute__((ext_vector_type(2)));
                    u32x2_ w0, w1; w0.x = pk_bf16(v0[0], v0[1]); w0.y = pk_bf16(v0[2], v0[3]); w1.x = pk_bf16(v1[0], v1[1]); w1.y = pk_bf16(v1[2], v1[3]);
                    *(u32x2_*)(p + 4 * g) = w0; *(u32x2_*)(p + 8 + 4 * g) = w1;
                }
    }
};
}

#ifndef MK_SINGLE
#define MK_SINGLE 0
#endif
constexpr int NWAVES = 8;
constexpr int S = 8192, D = 2048, FF = 5632, NL = 4;
constexpr int IN_COLS = 5696, ZC = 5888;
constexpr int ZC_SBQ = 0, ZC_SBK = 512, ZC_SBV = 1024, ZC_CQ = 1536, ZC_CKV = 2048, ZC_KR = 2304, ZC_RW = 2560;
constexpr float EPS = 1e-6f;
enum { I_X = 0, I_POS, I_F1N, I_F1G, I_F1U, I_F1D, I_MIXN, I_WIN, I_QN, I_WUQ, I_KVN, I_WUKV, I_MU, I_W0, I_W2, I_A0, I_A2, I_G2, I_KK, I_KA, I_RK, I_LNW, I_LNB,
       I_SBN, I_MLAN, I_WOUT, I_F2N, I_F2G, I_F2U, I_F2D, I_FN, N_IN };

constexpr size_t MiB = 1u << 20;
constexpr size_t WS_CTL = 0, CTL_ZERO_BYTES = 1 * MiB;
constexpr size_t WS_COS = 1 * MiB, WS_SIN = 2 * MiB;
constexpr size_t WS_W = 4 * MiB;
constexpr size_t W_GU0 = WS_W, W_DN0 = WS_W + 44 * MiB, W_GU1 = WS_W + 66 * MiB, W_DN1 = WS_W + 110 * MiB, W_IN = WS_W + 132 * MiB, W_OUT = WS_W + 155 * MiB,
                 W_UQ = WS_W + 163 * MiB, W_UKVV = WS_W + 163 * MiB + 768 * 1024, W_UKV = WS_W + 164 * MiB, W_LORA = WS_W + 165 * MiB;
constexpr size_t WS_HN = 172 * MiB, WS_CAT = 204 * MiB, WS_M = 236 * MiB;
constexpr size_t WS_Z = WS_M, WS_H = WS_M;
constexpr size_t WS_QS = WS_M + 184 * MiB, WS_KS = WS_M + 192 * MiB, WS_VS = WS_M + 200 * MiB, WS_CQN = WS_M + 208 * MiB, WS_CKVN = WS_M + 216 * MiB, WS_LORAA = WS_M + 220 * MiB;
constexpr size_t WS_PO = WS_M + 536 * MiB;
constexpr size_t WS_PML = WS_M + 648 * MiB;
constexpr int CW_QUEUE = 16384;
constexpr size_t WS_CHK = WS_M + 696 * MiB;
constexpr size_t WS_QMF = WS_M + 224 * MiB, WS_KVMF = WS_M + 248 * MiB, WS_LOF = WS_M + 280 * MiB;
constexpr size_t WS_QM = WS_M + 376 * MiB, WS_KM = WS_M + 388 * MiB, WS_VM = WS_M + 400 * MiB, WS_VT = WS_VM;
constexpr size_t WS_RR = WS_M + 408 * MiB, WS_RW = WS_M + 440 * MiB, WS_RK = WS_M + 472 * MiB, WS_RV = WS_M + 504 * MiB, WS_RKK = WS_M + 536 * MiB, WS_RB = WS_M + 568 * MiB, WS_RG = WS_M + 600 * MiB;
constexpr size_t WS_YSB = WS_M + 632 * MiB, WS_YMLA = WS_M + 648 * MiB, WS_YRW = WS_M + 664 * MiB;
constexpr size_t WS_END0 = WS_M + 696 * MiB;
constexpr size_t WB_DELTA = WS_END0 + 152 * MiB - WS_W;
constexpr size_t WS_XB = WS_END0 + 152 * MiB + 168 * MiB;
constexpr size_t WS_PART = WS_XB + 32 * MiB;
constexpr size_t WS_END = WS_PART + 1 * MiB;
constexpr int CW_CQ = 20480, CW_DONE = 24576;
constexpr int CW_BAR = 4096;

constexpr int RING_BYTES = 131072, LDS_BYTES = 163840, MISC_OFF = LDS_BYTES - 512;

namespace pg8 {
struct EpiQM {
    static constexpr bool PERM = true, AFTER_DRAIN = false;
    unsigned char* ws;
    __device__ __forceinline__ void operator()(const f32x4 (&acc)[2][2][4][2], const Unit& u, int wr, int wc, int fr, int fq) const {
        const int row0 = u.pm * BM + wr * 64 + fr, col0 = u.pn * BM + wc * 32 + 8 * fq;
        bf16_t* C = (bf16_t*)(ws + WS_QM); const float* ct = (const float*)(ws + WS_COS); const float* st = (const float*)(ws + WS_SIN);
        const float scale = 0.07216878364870322f * 1.4426950408889634f;
#pragma unroll
        for (int bj = 0; bj < 2; ++bj) {
            const int col = col0 + bj * HALF, d = col % 192;
#pragma unroll
            for (int ai = 0; ai < 2; ++ai)
#pragma unroll
                for (int m = 0; m < 4; ++m) {
                    const int row = row0 + ai * HALF + m * 16;
                    f32x4 v0 = acc[ai][bj][m][0] * scale, v1 = acc[ai][bj][m][1] * scale;
                    if (d >= 128) {
                        const int i0 = (d - 128) >> 1;
                        const f32x4 cs = *(const f32x4*)(ct + (size_t)row * 32 + i0), sn = *(const f32x4*)(st + (size_t)row * 32 + i0);
                        const f32x4 a0 = v0, a1 = v1;
                        v0.x = a0.x * cs.x - a0.y * sn.x; v0.y = a0.x * sn.x + a0.y * cs.x; v0.z = a0.z * cs.y - a0.w * sn.y; v0.w = a0.z * sn.y + a0.w * cs.y;
                        v1.x = a1.x * cs.z - a1.y * sn.z; v1.y = a1.x * sn.z + a1.y * cs.z; v1.z = a1.z * cs.w - a1.w * sn.w; v1.w = a1.z * sn.w + a1.w * cs.w;
                    }
                    u32x4 w; w.x = pk_bf16(v0[0], v0[1]); w.y = pk_bf16(v0[2], v0[3]); w.z = pk_bf16(v1[0], v1[1]); w.w = pk_bf16(v1[2], v1[3]);
                    *(u32x4*)(C + (size_t)row * 768 + col) = w;
                }
        }
    }
};
struct EpiKM {
    static constexpr bool PERM = true, AFTER_DRAIN = false;
    unsigned char* ws;
    __device__ __forceinline__ void operator()(const f32x4 (&acc)[2][2][4][2], const Unit& u, int wr, int wc, int fr, int fq) const {
        const int row0 = u.pm * BM + wr * 64 + fr, col0 = u.pn * BM + wc * 32 + 8 * fq;
        bf16_t* C = (bf16_t*)(ws + WS_KM);
#pragma unroll
        for (int ai = 0; ai < 2; ++ai)
#pragma unroll
            for (int m = 0; m < 4; ++m)
#pragma unroll
                for (int bj = 0; bj < 2; ++bj) {
                    const int col = col0 + bj * HALF;
                    const f32x4 v0 = acc[ai][bj][m][0], v1 = acc[ai][bj][m][1];
                    u32x4 w; w.x = pk_bf16(v0[0], v0[1]); w.y = pk_bf16(v0[2], v0[3]); w.z = pk_bf16(v1[0], v1[1]); w.w = pk_bf16(v1[2], v1[3]);
                    *(u32x4*)(C + (size_t)(row0 + ai * HALF + m * 16) * 768 + 192 * (col >> 7) + (col & 127)) = w;
                }
    }
};
}

#define DI __device__ __forceinline__
typedef unsigned short bf16;
typedef unsigned v4u __attribute__((ext_vector_type(4)));
typedef unsigned v2u __attribute__((ext_vector_type(2)));
typedef float f32x4 __attribute__((ext_vector_type(4)));
typedef float f32x2 __attribute__((ext_vector_type(2)));
#define LDS_WAIT() asm volatile("s_waitcnt lgkmcnt(0)" ::: "memory")
DI float bf2f(unsigned b) { return __uint_as_float(b << 16); }
DI float bflo(unsigned w) { return __uint_as_float(w << 16); }
DI float bfhi(unsigned w) { return __uint_as_float(w & 0xffff0000u); }
DI unsigned pk2(float lo, float hi) { return pg8::pk_bf16(lo, hi); }
DI float sq8(const v4u& w) { return (bflo(w.x) * bflo(w.x) + bfhi(w.x) * bfhi(w.x)) + (bflo(w.y) * bflo(w.y) + bfhi(w.y) * bfhi(w.y)) + (bflo(w.z) * bflo(w.z) + bfhi(w.z) * bfhi(w.z)) + (bflo(w.w) * bflo(w.w) + bfhi(w.w) * bfhi(w.w)); }
template <int CTRL> DI float dpp_add(float v) { return v + __builtin_bit_cast(float, __builtin_amdgcn_update_dpp(0, __builtin_bit_cast(int, v), CTRL, 0xf, 0xf, true)); }
DI float row16_sum(float v) { v = dpp_add<0xB1>(v); v = dpp_add<0x4E>(v); v = dpp_add<0x141>(v); v = dpp_add<0x140>(v); return v; }
DI float wave_sum(float v) {
    v = row16_sum(v);
    return (__builtin_bit_cast(float, __builtin_amdgcn_readlane(__builtin_bit_cast(int, v), 0)) + __builtin_bit_cast(float, __builtin_amdgcn_readlane(__builtin_bit_cast(int, v), 16)))
         + (__builtin_bit_cast(float, __builtin_amdgcn_readlane(__builtin_bit_cast(int, v), 32)) + __builtin_bit_cast(float, __builtin_amdgcn_readlane(__builtin_bit_cast(int, v), 48)));
}
template <int W> DI float grp_sum(float v) {
    v = dpp_add<0xB1>(v); v = dpp_add<0x4E>(v);
    if (W >= 8) v = dpp_add<0x141>(v);
    if (W >= 16) v = dpp_add<0x140>(v);
    return v;
}
DI float sigmoid_f(float x) { return __builtin_amdgcn_rcpf(1.f + __expf(-x)); }
DI float softplus_f(float x) { return fmaxf(x, 0.f) + __logf(1.f + __expf(-fabsf(x))); }
DI float tanh_f(float x) { const float xc = fminf(fmaxf(x, -15.f), 15.f); const float t = __expf(2.f * xc); return (t - 1.f) * __builtin_amdgcn_rcpf(t + 1.f); }

DI int fresh_tid(int wave) { int l_; asm volatile("v_mbcnt_lo_u32_b32 %0, -1, 0\n\tv_mbcnt_hi_u32_b32 %0, -1, %0" : "=v"(l_)); return (wave << 6) | l_; }
DI f32x4 ldz4(const bf16* p) { const v2u w = *(const v2u*)p; return (f32x4){bflo(w.x), bfhi(w.x), bflo(w.y), bfhi(w.y)}; }
DI f32x2 ldz2(const bf16* p) { const unsigned w = *(const unsigned*)p; return (f32x2){bflo(w), bfhi(w)}; }
struct Args { const float* in[N_IN]; float* out; unsigned char* ws; int ph_lo, ph_hi; };
typedef const __attribute__((address_space(4))) unsigned char* kaptr_t;
struct KA { kaptr_t p;
    DI const float* in(int i) const { return *(const float* const __attribute__((address_space(4)))*)(p + 8 * i); }
    DI float* out() const { return *(float* const __attribute__((address_space(4)))*)(p + 8 * N_IN); }
    DI unsigned char* ws() const { return *(unsigned char* const __attribute__((address_space(4)))*)(p + 8 * N_IN + 8); } };

struct TI { const float* W; bf16* WT; int N, k0, n0, ldk, drow0, kcol0; const float* gk; int rs; };
DI void ti_load(const TI& t, float (&wv)[32], int lane) {
#pragma unroll
    for (int i = 0; i < 32; ++i) { const int kk = 2 * i + (lane >> 5); wv[i] = __builtin_nontemporal_load(t.W + (size_t)(t.k0 + kk) * t.N + t.n0 + (lane & 31)); }
}
DI void ti_store(const TI& t, const float (&wv)[32], LAS float* scr, int lane) {
#pragma unroll
    for (int i = 0; i < 32; ++i) { const int kk = 2 * i + (lane >> 5); scr[kk * 33 + (lane & 31)] = wv[i]; }
    LDS_WAIT(); asm volatile("" ::: "memory");
    const int c = lane & 7;
    f32x4 g0 = {1.f, 1.f, 1.f, 1.f}, g1 = g0;
    if (t.gk) { g0 = *(const f32x4*)(t.gk + 8 * c); g1 = *(const f32x4*)(t.gk + 8 * c + 4); }
#pragma unroll
    for (int j = 0; j < 4; ++j) { const int n = (lane >> 3) + 8 * j; const LAS float* s = scr + (8 * c) * 33 + n;
        v4u o; o.x = pk2(s[0 * 33] * g0.x, s[1 * 33] * g0.y); o.y = pk2(s[2 * 33] * g0.z, s[3 * 33] * g0.w); o.z = pk2(s[4 * 33] * g1.x, s[5 * 33] * g1.y); o.w = pk2(s[6 * 33] * g1.z, s[7 * 33] * g1.w);
        __builtin_nontemporal_store(o, (v4u*)(t.WT + (size_t)(t.drow0 + n * t.rs) * t.ldk + t.kcol0 + t.k0 + 8 * c)); }
    LDS_WAIT(); asm volatile("" ::: "memory");
}

namespace cv {
constexpr int I_FF = (D / 64) * (FF / 32);
constexpr int I_IN = (D / 64) * (IN_COLS / 32);
constexpr int I_OUT = (D / 64) * (D / 32);
constexpr int I_UQ = (512 / 64) * (768 / 32), I_UKV = 64, N_W2 = 32, N_A2 = 32, N_G2 = 64;
constexpr int I_UKVV = 64;
constexpr int TOTAL = 6 * I_FF + I_IN + I_OUT + I_UQ + I_UKV + I_UKVV + N_W2 + N_A2 + N_G2;
}
DI TI conv_params(const KA& a, int l, unsigned char* ws, int it) {
    using namespace cv;
        int r = it;
        if (r < 6 * I_FF) {
            const int m = r / I_FF; r -= m * I_FF; const int f = m / 3, t = m % 3;
            if (t < 2) {
                const float* src = (f ? (t ? a.in(I_F2U) : a.in(I_F2G)) : (t ? a.in(I_F1U) : a.in(I_F1G))) + (size_t)l * D * FF;
                const int nblk = FF / 32, kb = r / nblk, nb = r % nblk, n0 = 32 * nb;
                return TI{src, (bf16*)(ws + (f ? W_GU1 : W_GU0)), FF, 64 * kb, n0, D, 256 * (n0 >> 7) + (n0 & 127) + 128 * t, 0, (f ? a.in(I_F2N) : a.in(I_F1N)) + l * D + 64 * kb, 1};
            } else {
                const float* src = (f ? a.in(I_F2D) : a.in(I_F1D)) + (size_t)l * FF * D;
                const int nblk = D / 32, kb = r / nblk, nb = r % nblk, n0 = 32 * nb;
                return TI{src, (bf16*)(ws + (f ? W_DN1 : W_DN0)), D, 64 * kb, n0, FF, n0, 0, nullptr, 1};
            }

        }
        r -= 6 * I_FF;
        if (r < I_IN) { const int nblk = IN_COLS / 32, kb = r / nblk, nb = r % nblk, n0 = 32 * nb;
            return TI{a.in(I_WIN) + (size_t)l * D * IN_COLS, (bf16*)(ws + W_IN), IN_COLS, 64 * kb, n0, D, n0 < 2368 ? n0 : n0 + 192, 0, a.in(I_MIXN) + l * D + 64 * kb, 1}; }
        r -= I_IN;
        if (r < I_OUT) { const int nblk = D / 32, kb = r / nblk, nb = r % nblk, n0 = 32 * nb;
            return TI{a.in(I_WOUT) + (size_t)l * D * D, (bf16*)(ws + W_OUT), D, 64 * kb, n0, D, n0, 0, nullptr, 1}; }
        r -= I_OUT;
        if (r < I_UQ) { const int nblk = 768 / 32, kb = r / nblk, nb = r % nblk, n0 = 32 * nb, hb = nb / 6, b = nb % 6;
            return TI{a.in(I_WUQ) + (size_t)l * 512 * 768, (bf16*)(ws + W_UQ), 768, 64 * kb, n0, 512, b < 4 ? n0 : 192 * hb + 128 + (b - 4), 0, nullptr, b < 4 ? 1 : 2}; }
        r -= I_UQ;
        if (r < I_UKV) { const int kb = r >> 4, vb = r & 15, n0 = 256 * (vb >> 2) + 32 * (vb & 3);
            return TI{a.in(I_WUKV) + (size_t)l * 256 * 1024, (bf16*)(ws + W_UKV), 1024, 64 * kb, n0, 256, 128 * (vb >> 2) + 32 * (vb & 3), 0, nullptr, 1}; }
        r -= I_UKV;
        if (r < I_UKVV) { const int kb = r >> 4, vb = r & 15, n0 = 256 * (vb >> 2) + 128 + 32 * (vb & 3);
            return TI{a.in(I_WUKV) + (size_t)l * 256 * 1024, (bf16*)(ws + W_UKVV), 1024, 64 * kb, n0, 256, 128 * (vb >> 2) + 32 * (vb & 3), 0, nullptr, 1}; }
        r -= I_UKVV;
        if (r < N_W2) { const int n0 = 32 * r;
            return TI{a.in(I_W2) + (size_t)l * 64 * 1024, (bf16*)(ws + W_LORA), 1024, 0, n0, 256, 2 * n0, 0, nullptr, 2}; }
        r -= N_W2;
        if (r < N_A2) { const int n0 = 32 * r;
            return TI{a.in(I_A2) + (size_t)l * 64 * 1024, (bf16*)(ws + W_LORA), 1024, 0, n0, 256, 2 * n0 + 1, 64, nullptr, 2}; }
        r -= N_A2;
        { const int kb = r / 32, nb = r % 32, n0 = 32 * nb;
            return TI{a.in(I_G2) + (size_t)l * 128 * 1024, (bf16*)(ws + W_LORA), 1024, 64 * kb, n0, 256, 2048 + n0, 128, nullptr, 1}; }
}
DI void conv_phase(const KA& a, int l, LAS unsigned char* lds, int gw, int ngw, int wave, int lane) {
    LAS float* scr = (LAS float*)(lds + wave * 16384);
    unsigned char* ws = a.ws();
    for (int it = gw; it < cv::TOTAL; it += 2 * ngw) {
        const TI ta = conv_params(a, l, ws, it); const bool hb = it + ngw < cv::TOTAL; const TI tb = conv_params(a, l, ws, hb ? it + ngw : it);
        float wa[32], wb[32];
        ti_load(ta, wa, lane); if (hb) ti_load(tb, wb, lane);
        ti_store(ta, wa, scr, lane); if (hb) ti_store(tb, wb, scr, lane);
    }
    unsigned zz = 0u; asm volatile("" : "+v"(zz)); const v4u zv = {zz, zz, zz, zz};
    for (int i = gw * 64 + lane; i < 3072 * 32; i += ngw * 64) {
        const int row = i >> 5, ch = i & 31, blk = row >> 10;
        const bool data = blk < 2 ? ((row & 1) ? (ch >= 8 && ch < 16) : (ch < 8)) : (ch >= 16);
        if (!data) *(v4u*)((bf16*)(ws + W_LORA) + (size_t)row * 256 + 8 * ch) = zv;
    }
    for (int i = gw * 64 + lane; i < 192 * (D / 8); i += ngw * 64) *(v4u*)((bf16*)(ws + W_IN) + (size_t)2368 * D + (size_t)i * 8) = zv;
    if (l == 0) {
        for (int t = gw; t < S; t += ngw) {
            const f32x4* xr = (const f32x4*)(a.in(I_X) + (size_t)t * D) + 2 * lane; v4u* xo = (v4u*)((bf16*)(ws + WS_XB) + (size_t)t * D) + lane; float ss = 0.f;
#pragma unroll
            for (int j = 0; j < 4; ++j) { const f32x4 v0 = __builtin_nontemporal_load(xr + 128 * j), v1 = __builtin_nontemporal_load(xr + 128 * j + 1); v4u w; w.x = pk2(v0.x, v0.y); w.y = pk2(v0.z, v0.w); w.z = pk2(v1.x, v1.y); w.w = pk2(v1.z, v1.w); xo[64 * j] = w; ss += sq8(w); }
            ss = wave_sum(ss);
            if (lane == 0) { float z0 = 0.f; asm volatile("" : "+v"(z0)); f32x4* pp = (f32x4*)((float*)(ws + WS_PART) + (size_t)t * 8); pp[0] = (f32x4){ss, z0, z0, z0}; pp[1] = (f32x4){z0, z0, z0, z0}; }
        }
        const int* pos = (const int*)a.in(I_POS); float* ct = (float*)(ws + WS_COS); float* st = (float*)(ws + WS_SIN);
        for (int i = gw * 64 + lane; i < S * 32; i += ngw * 64) {
            const int t = i >> 5, j = i & 31;
            const float inv_freq = expf(-(float)j * (1.f / 32.f) * 9.210340371976184f);
            const float ang = (float)pos[t] * inv_freq;
            const double rev = (double)ang * 0.15915494309189535; const float fr = (float)(rev - __builtin_rint(rev));
            ct[i] = __builtin_amdgcn_cosf(fr); st[i] = __builtin_amdgcn_sinf(fr);
        }
    }
}

constexpr int CQ_BLK = (cv::TOTAL + 7) / 8, CQ_ZCH = 3072 * 32 + 192 * (D / 8), CQ_ZERO = (CQ_ZCH + 4095) / 4096, CQ_ITEMS = CQ_BLK + CQ_ZERO;
DI void conv_queue_item(const KA& a, int L, unsigned char* wsw, int ci, int tid_in, LAS unsigned char* lds) {
    int tc = tid_in; asm volatile("" : "+v"(tc));
    const int wave = tc >> 6, lane = tc & 63;
    if (ci < CQ_BLK) {
        const int it = ci * 8 + wave;
        if (it < cv::TOTAL) { const TI t = conv_params(a, L, wsw, it); float wv[32]; ti_load(t, wv, lane); ti_store(t, wv, (LAS float*)(lds + wave * 16384), lane); }
    } else {
        unsigned zz = 0u; asm volatile("" : "+v"(zz)); const v4u zv = {zz, zz, zz, zz};
#pragma unroll
        for (int k = 0; k < 8; ++k) {
            const int i = (ci - CQ_BLK) * 4096 + k * 512 + tc;
            if (i < 3072 * 32) { const int row = i >> 5, ch = i & 31, blk = row >> 10;
                const bool data = blk < 2 ? ((row & 1) ? (ch >= 8 && ch < 16) : (ch < 8)) : (ch >= 16);
                if (!data) *(v4u*)((bf16*)(wsw + W_LORA) + (size_t)row * 256 + 8 * ch) = zv; }
            else if (i < CQ_ZCH) *(v4u*)((bf16*)(wsw + W_IN) + (size_t)2368 * D + (size_t)(i - 3072 * 32) * 8) = zv;
        }
    }
}
DI void conv_harvest(const KA& a, int L, int ph, int G, int tid, LAS unsigned char* lds) {
    unsigned char* ws = a.ws(); unsigned char* wsw = ws + ((L & 1) ? WB_DELTA : 0);
    unsigned* cq = (unsigned*)(ws + WS_CTL) + CW_CQ + 64 * L; unsigned* done = (unsigned*)(ws + WS_CTL) + CW_DONE + 64 * (ph < 0 ? 0 : ph);
    volatile LAS unsigned* slot = (volatile LAS unsigned*)(lds + MISC_OFF + 64);
    __syncthreads();
    if (ph >= 0 && tid == 0) (void)__hip_atomic_fetch_add(done, 1u, __ATOMIC_RELAXED, __HIP_MEMORY_SCOPE_AGENT);
    for (;;) {
        if (tid == 0) {
            unsigned it = 0x7fffffffu;
            if (ph < 0 || __hip_atomic_load(done, __ATOMIC_RELAXED, __HIP_MEMORY_SCOPE_AGENT) < (unsigned)G) it = __hip_atomic_fetch_add(cq, 1u, __ATOMIC_RELAXED, __HIP_MEMORY_SCOPE_AGENT);
            *slot = it;
        }
        __syncthreads();
        const int ci = (int)*slot;
        __syncthreads();
        if (ci >= CQ_ITEMS) break;
        conv_queue_item(a, L, wsw, ci, tid, lds);
    }
}
DI void rstd_table(const pg8::StaticOrder& So, const float* part, LAS _Float16* rt, int tid) {
    if (tid < 256) {
        pg8::Unit u;
#pragma unroll
        for (int i = 0; i < 6; ++i) if (So.next(i, u)) rt[u.pm * 256 + tid] = (_Float16)pg8::row_rstd(part, u.pm * 256 + tid);
#pragma unroll 1
        for (int i = 6; So.next(i, u); ++i) rt[u.pm * 256 + tid] = (_Float16)pg8::row_rstd(part, u.pm * 256 + tid);
    }
    __syncthreads();
}
DI void rms_row_bf16(const bf16* xrow, const float* g, bf16* orow, int lane) {
    const v4u* xr = (const v4u*)xrow + lane; const f32x4* gr = (const f32x4*)g + 2 * lane;
    v4u v[4]; float s = 0.f;
#pragma unroll
    for (int j = 0; j < 4; ++j) { v[j] = xr[64 * j]; s += sq8(v[j]); }
    const float rstd = 1.f / sqrtf(wave_sum(s) * (1.f / D) + EPS);
    v4u* o = (v4u*)orow + lane;
#pragma unroll
    for (int j = 0; j < 4; ++j) { const f32x4 g0 = gr[128 * j], g1 = gr[128 * j + 1]; v4u w;
        w.x = pk2(bflo(v[j].x) * rstd * g0.x, bfhi(v[j].x) * rstd * g0.y); w.y = pk2(bflo(v[j].y) * rstd * g0.z, bfhi(v[j].y) * rstd * g0.w);
        w.z = pk2(bflo(v[j].z) * rstd * g1.x, bfhi(v[j].z) * rstd * g1.y); w.w = pk2(bflo(v[j].w) * rstd * g1.z, bfhi(v[j].w) * rstd * g1.w); o[64 * j] = w; }
}
DI void norm_phase(const bf16* x, const float* g, bf16* hn, int gw, int ngw, int lane) {
    for (int t = gw; t < S; t += ngw) rms_row_bf16(x + (size_t)t * D, g, hn + (size_t)t * D, lane);
}
DI void final_phase(const bf16* x, float* out, const float* g, int gw, int ngw, int lane) {
    for (int t = gw; t < S; t += ngw) {
        const v4u* xr = (const v4u*)(x + (size_t)t * D) + lane; const f32x4* gr = (const f32x4*)g + 2 * lane; f32x4* orow = (f32x4*)(out + (size_t)t * D) + 2 * lane;
        v4u v[4]; float s = 0.f;
#pragma unroll
        for (int j = 0; j < 4; ++j) { v[j] = xr[64 * j]; s += sq8(v[j]); }
        const float rstd = 1.f / sqrtf(wave_sum(s) * (1.f / D) + EPS);
#pragma unroll
        for (int j = 0; j < 4; ++j) { const f32x4 g0 = gr[128 * j], g1 = gr[128 * j + 1];
            __builtin_nontemporal_store((f32x4){bflo(v[j].x), bfhi(v[j].x), bflo(v[j].y), bfhi(v[j].y)} * rstd * g0, orow + 128 * j); __builtin_nontemporal_store((f32x4){bflo(v[j].z), bfhi(v[j].z), bflo(v[j].w), bfhi(v[j].w)} * rstd * g1, orow + 128 * j + 1); }
    }
}

DI void prep1_phase(const KA& a, int l, int gw, int ngw, int lane) {
    unsigned char* ws = a.ws();
    const bf16* Z = (const bf16*)(ws + WS_Z);
    bf16* QS = (bf16*)(ws + WS_QS); bf16* KS = (bf16*)(ws + WS_KS); bf16* VS = (bf16*)(ws + WS_VS);
    bf16* CQN = (bf16*)(ws + WS_CQN); bf16* CKVN = (bf16*)(ws + WS_CKVN); bf16* LA = (bf16*)(ws + WS_LORAA);
    unsigned* RKP = (unsigned*)(ws + WS_RR); bf16* VB = (bf16*)(ws + WS_RV);
    const float* qn = a.in(I_QN) + l * 512; const float* kvn = a.in(I_KVN) + l * 256; const float* mu = a.in(I_MU) + l * 3328;
    const float sbscale = 0.08838834764831845f;
    for (int t = gw; t < S; t += ngw) {
        const bf16* z = Z + (size_t)t * ZC;
        {
            const f32x4 c0 = ldz4(z + ZC_CQ + 8 * lane), c1 = ldz4(z + ZC_CQ + 8 * lane + 4);
            float s = (c0.x * c0.x + c0.y * c0.y) + (c0.z * c0.z + c0.w * c0.w) + (c1.x * c1.x + c1.y * c1.y) + (c1.z * c1.z + c1.w * c1.w);
            const float rstd = 1.f / sqrtf(wave_sum(s) * (1.f / 512.f) + EPS);
            const f32x4 g0 = *(const f32x4*)(qn + 8 * lane), g1 = *(const f32x4*)(qn + 8 * lane + 4);
            v4u w; w.x = pk2(c0.x * rstd * g0.x, c0.y * rstd * g0.y); w.y = pk2(c0.z * rstd * g0.z, c0.w * rstd * g0.w);
            w.z = pk2(c1.x * rstd * g1.x, c1.y * rstd * g1.y); w.w = pk2(c1.z * rstd * g1.z, c1.w * rstd * g1.w);
            *(v4u*)(CQN + (size_t)t * 512 + 8 * lane) = w;
        }
        {
            const f32x4 c0 = ldz4(z + ZC_CKV + 4 * lane);
            float s = (c0.x * c0.x + c0.y * c0.y) + (c0.z * c0.z + c0.w * c0.w);
            const float rstd = 1.f / sqrtf(wave_sum(s) * (1.f / 256.f) + EPS);
            const f32x4 g0 = *(const f32x4*)(kvn + 4 * lane);
            v2u w; w.x = pk2(c0.x * rstd * g0.x, c0.y * rstd * g0.y); w.y = pk2(c0.z * rstd * g0.z, c0.w * rstd * g0.w);
            *(v2u*)(CKVN + (size_t)t * 256 + 4 * lane) = w;
        }
        {
            const bf16* zr = z + ZC_RW; const bf16* zp = zr - ZC; const bool has_prev = t > 0;
#pragma unroll
            for (int j = 0; j < 4; ++j) {
                f32x4 x3[3];
#pragma unroll
                for (int part = 0; part < 3; ++part) { const int c = part * 1024 + 4 * lane + 256 * j;
                    const f32x4 zc = ldz4(zr + c); f32x4 zq = {0.f, 0.f, 0.f, 0.f}; if (has_prev) zq = ldz4(zp + c);
                    const f32x4 m = *(const f32x4*)(mu + c); x3[part] = zc + (zq - zc) * m; }
                v4u wrk; wrk.x = pk2(x3[0].x, x3[1].x); wrk.y = pk2(x3[0].y, x3[1].y); wrk.z = pk2(x3[0].z, x3[1].z); wrk.w = pk2(x3[0].w, x3[1].w);
                *(v4u*)(RKP + (size_t)t * 1024 + 4 * lane + 256 * j) = wrk;
                v2u wv; wv.x = pk2(x3[2].x, x3[2].y); wv.y = pk2(x3[2].z, x3[2].w);
                *(v2u*)(VB + (size_t)t * 1024 + 4 * lane + 256 * j) = wv;
            }
            { const int c = 3072 + lane; const float zc = bf2f(zr[c]), zq = has_prev ? bf2f(zp[c]) : 0.f; const float xw = zc + (zq - zc) * mu[c];
              const int c2 = 3136 + lane; const float zc2 = bf2f(zr[c2]), zq2 = has_prev ? bf2f(zp[c2]) : 0.f; const float xa = zc2 + (zq2 - zc2) * mu[c2];
              const int c3 = 3200 + 2 * lane; const f32x2 zc3 = ldz2(zr + c3); f32x2 zq3 = {0.f, 0.f}; if (has_prev) zq3 = ldz2(zp + c3);
              const f32x2 m3 = *(const f32x2*)(mu + c3); const f32x2 xg = zc3 + (zq3 - zc3) * m3;
              bf16* la = LA + (size_t)t * 256;
              la[lane] = (bf16)(pk2(tanh_f(xw), 0.f) & 0xffffu); la[64 + lane] = (bf16)(pk2(xa, 0.f) & 0xffffu);
              *(unsigned*)(la + 128 + 2 * lane) = pk2(sigmoid_f(xg.x), sigmoid_f(xg.y)); }
        }
    }
}

DI void prep2_phase(const KA& a, int l, int gw, int ngw, int lane) {
    unsigned char* ws = a.ws();
    const bf16* Z = (const bf16*)(ws + WS_Z); const float* CT = (const float*)(ws + WS_COS); const float* ST = (const float*)(ws + WS_SIN); bf16* KM = (bf16*)(ws + WS_KM);
    for (int t = gw; t < S; t += ngw) {
        const bf16* kr = Z + (size_t)t * ZC + ZC_KR; bf16* km = KM + (size_t)t * 768;
        const int i32 = lane & 31, hb = 2 * (lane >> 5); const float cs = CT[t * 32 + i32], sn = ST[t * 32 + i32];
        const float kr1 = bf2f(kr[i32]), kr2 = bf2f(kr[32 + i32]);
        const unsigned w = pk2(kr1 * cs - kr2 * sn, kr1 * sn + kr2 * cs);
        *(unsigned*)(km + 192 * hb + 128 + 2 * i32) = w; *(unsigned*)(km + 192 * (hb + 1) + 128 + 2 * i32) = w;
    }
}

DI float dot2bf(unsigned a, unsigned b, float c) { return __builtin_amdgcn_fdot2_f32_bf16(__builtin_bit_cast(pg8::bf16x2_t, a), __builtin_bit_cast(pg8::bf16x2_t, b), c, false); }
constexpr int SB_PF = 6, SB_NR = 7, SB_RING = SB_NR * 2048;
template <int SB_PF, int SB_NR> DI void sb_item(const bf16* __restrict__ QS, const bf16* __restrict__ KS, const bf16* __restrict__ VS, bf16* __restrict__ Y, int h, int grp, int lane, LAS unsigned char* ring) {
    const int ql = lane >> 2, c = lane & 3, t = 16 * grp + ql, co = 128 * h + 32 * c;
    unsigned q[16]; float o[32];
    { const v4u* qp = (const v4u*)(QS + (size_t)t * ZC + co);
#pragma unroll
      for (int j = 0; j < 4; ++j) { const v4u w = qp[j]; q[4 * j] = w.x; q[4 * j + 1] = w.y; q[4 * j + 2] = w.z; q[4 * j + 3] = w.w; } }
    asm volatile("s_waitcnt vmcnt(0)" ::: "memory");
#pragma unroll
    for (int j = 0; j < 16; ++j) asm volatile("" : "+v"(q[j]));
#pragma unroll
    for (int i = 0; i < 32; ++i) o[i] = 0.f;
    float R = 0.f;
    const int s_top = 16 * grp + 14, nr = s_top / 4 + 1;
    const int lu = lane >> 4;
    const bf16* kl = KS + 128 * h + 8 * (lane & 15); const bf16* vl = VS + 128 * h + 8 * (lane & 15);
    const LAS unsigned char* rd = ring + 64 * c;
#define SB_ISSUE(r) do { int s_ = s_top - 4 * (r) - lu; s_ = s_ >= 0 ? s_ : 0; LAS unsigned char* sl_ = ring + ((r) % SB_NR) * 2048; \
        __builtin_amdgcn_global_load_lds((const unsigned*)(kl + (size_t)s_ * ZC), (LAS unsigned*)sl_, 16, 0, 0); \
        __builtin_amdgcn_global_load_lds((const unsigned*)(vl + (size_t)s_ * ZC), (LAS unsigned*)(sl_ + 1024), 16, 0, 0); } while (0)
#pragma unroll 1
    for (int r = 0; r < SB_PF; ++r) SB_ISSUE(r);
#pragma unroll 1
    for (int r = 0; r < nr; ++r) {
        SB_ISSUE(r + SB_PF);
        if constexpr (SB_PF == 6) asm volatile("s_waitcnt vmcnt(12)" ::: "memory"); else asm volatile("s_waitcnt vmcnt(6)" ::: "memory");
        static_assert(SB_PF == 6 || SB_PF == 3, "counted wait");
        const LAS unsigned char* sl = rd + (r % SB_NR) * 2048;
        const int s0 = s_top - 4 * r;
        float av[4];
#pragma unroll
        for (int u = 0; u < 4; ++u) { float z0 = 0.f, z1 = 0.f;
#pragma unroll
            for (int j = 0; j < 4; ++j) { const v4u kw = *(const LAS v4u*)(sl + 256 * u + 16 * j);
                z0 = dot2bf(kw.x, q[4 * j], z0); z1 = dot2bf(kw.y, q[4 * j + 1], z1); z0 = dot2bf(kw.z, q[4 * j + 2], z0); z1 = dot2bf(kw.w, q[4 * j + 3], z1); }
            const float z = grp_sum<4>(z0 + z1) * 0.08838834764831845f;
            const int s = s0 - u; const bool valid = s >= 0 && s < t;
            const float sp = valid ? softplus_f(z) : 0.f; R += sp; av[u] = valid ? __expf(z - R) : 0.f; }
#pragma unroll
        for (int u = 0; u < 4; ++u) {
            const unsigned alo = pk2(av[u], 0.f), ahi = alo << 16;
#pragma unroll
            for (int j = 0; j < 4; ++j) { const v4u vw = *(const LAS v4u*)(sl + 1024 + 256 * u + 16 * j);
                o[8 * j] = dot2bf(vw.x, alo, o[8 * j]); o[8 * j + 1] = dot2bf(vw.x, ahi, o[8 * j + 1]); o[8 * j + 2] = dot2bf(vw.y, alo, o[8 * j + 2]); o[8 * j + 3] = dot2bf(vw.y, ahi, o[8 * j + 3]);
                o[8 * j + 4] = dot2bf(vw.z, alo, o[8 * j + 4]); o[8 * j + 5] = dot2bf(vw.z, ahi, o[8 * j + 5]); o[8 * j + 6] = dot2bf(vw.w, alo, o[8 * j + 6]); o[8 * j + 7] = dot2bf(vw.w, ahi, o[8 * j + 7]); }
        }
        asm volatile("s_waitcnt lgkmcnt(0)" ::: "memory");
        if (__all(R > 44.f)) break;
    }
#undef SB_ISSUE
    asm volatile("s_waitcnt vmcnt(0)" ::: "memory");
    bf16* yp = Y + (size_t)t * 512 + co;
#pragma unroll
    for (int j = 0; j < 4; ++j) { v4u w; w.x = pk2(o[8 * j], o[8 * j + 1]); w.y = pk2(o[8 * j + 2], o[8 * j + 3]); w.z = pk2(o[8 * j + 4], o[8 * j + 5]); w.w = pk2(o[8 * j + 6], o[8 * j + 7]); *(v4u*)(yp + 8 * j) = w; }
}

typedef float f32x16 __attribute__((ext_vector_type(16)));
typedef short bf16x8 __attribute__((ext_vector_type(8)));
constexpr int ML_KSTR = 400, ML_VSTR = 144, ML_KB = 64 * ML_KSTR, ML_VB = 128 * ML_VSTR, ML_BUF = ML_KB + ML_VB;
DI int crow(int r, int hi) { return (r & 3) + 8 * (r >> 2) + 4 * hi; }
DI bf16x8 pack8(const f32x16& p, int b) { v4u w; w.x = pk2(p[b], p[b + 1]); w.y = pk2(p[b + 2], p[b + 3]); w.z = pk2(p[b + 4], p[b + 5]); w.w = pk2(p[b + 6], p[b + 7]); return __builtin_bit_cast(bf16x8, w); }
DI float half_swap_max(float v) { auto rr = __builtin_amdgcn_permlane32_swap(__float_as_uint(v), __float_as_uint(v), false, false); return fmaxf(__uint_as_float(rr[0]), __uint_as_float(rr[1])); }
DI float half_swap_sum(float v) { auto rr = __builtin_amdgcn_permlane32_swap(__float_as_uint(v), __float_as_uint(v), false, false); return __uint_as_float(rr[0]) + __uint_as_float(rr[1]); }
DI void mla_flash_unit(const bf16* __restrict__ QM, const bf16* __restrict__ KM, const bf16* __restrict__ VT, float* __restrict__ PO, float* __restrict__ ML, int h, int qb, int t_lo, int t_hi,
                       LAS unsigned char* lds, int tid) {
    const int lane = tid & 63, wave = __builtin_amdgcn_readfirstlane(tid >> 6), r32 = lane & 31, hi = lane >> 5;
    const int qw = qb * 256 + 32 * wave, qrow = qw + r32;
    bf16x8 qf[12];
    { const bf16* qp = QM + (size_t)qrow * 768 + 192 * h + 8 * hi;
#pragma unroll
      for (int ks = 0; ks < 12; ++ks) qf[ks] = *(const bf16x8*)(qp + 16 * ks); }
    asm volatile("s_waitcnt vmcnt(0)" ::: "memory");
#pragma unroll
    for (int ks = 0; ks < 12; ++ks) asm volatile("" : "+v"(qf[ks]));
    f32x16 o[4];
#pragma unroll
    for (int d = 0; d < 4; ++d)
#pragma unroll
        for (int r = 0; r < 16; ++r) o[d][r] = 0.f;
    float m = -1e30f, l = 0.f;
    const bf16* kbase = KM + 192 * h; const bf16* vbase = VT + (size_t)h * 128 * S;
    int krow[3], kch[3]; v4u sk[3], sv[2];
#pragma unroll
    for (int i = 0; i < 3; ++i) { const int id = tid + 512 * i; krow[i] = id / 24; kch[i] = id - 24 * krow[i]; }
    const int vd0 = tid >> 3, vc8 = tid & 7;
#define ML_LOAD(t) do { _Pragma("unroll") for (int i = 0; i < 3; ++i) sk[i] = *(const v4u*)(kbase + (size_t)(64 * (t) + krow[i]) * 768 + 8 * kch[i]); \
        _Pragma("unroll") for (int i = 0; i < 2; ++i) sv[i] = *(const v4u*)(vbase + (size_t)(vd0 + 64 * i) * S + 64 * (t) + 8 * vc8); } while (0)
#define ML_WRITE(b) do { LAS unsigned char* B_ = lds + (b) * ML_BUF; _Pragma("unroll") for (int i = 0; i < 3; ++i) *(LAS v4u*)(B_ + krow[i] * ML_KSTR + kch[i] * 16) = sk[i]; \
        _Pragma("unroll") for (int i = 0; i < 2; ++i) *(LAS v4u*)(B_ + ML_KB + (vd0 + 64 * i) * ML_VSTR + vc8 * 16) = sv[i]; } while (0)
#define ML_BAR() do { asm volatile("s_waitcnt lgkmcnt(0)" ::: "memory"); __builtin_amdgcn_s_barrier(); } while (0)
    const bool gB = wave >= 4;
    ML_LOAD(t_lo); ML_WRITE(t_lo & 1); __syncthreads();
    if (gB) { if (t_lo + 1 < t_hi) ML_LOAD(t_lo + 1); ML_BAR(); }
    for (int t = t_lo; t < t_hi; ++t) {
        const int k0 = 64 * t; const bool act = k0 <= qw + 31;
        f32x16 p0, p1;
        if (!gB && t + 1 < t_hi) ML_LOAD(t + 1);
        if (act) {
            const LAS unsigned char* Kb = lds + (t & 1) * ML_BUF + r32 * ML_KSTR + 16 * hi;
#pragma unroll
            for (int r = 0; r < 16; ++r) { p0[r] = 0.f; p1[r] = 0.f; }
            __builtin_amdgcn_s_setprio(1);
            {
                bf16x8 ka[3][2];
#pragma unroll
                for (int ks = 0; ks < 2; ++ks) { ka[ks][0] = *(const LAS bf16x8*)(Kb + 32 * ks); ka[ks][1] = *(const LAS bf16x8*)(Kb + 32 * ML_KSTR + 32 * ks); }
                __builtin_amdgcn_sched_barrier(0);
#pragma unroll
                for (int ks = 0; ks < 12; ++ks) {
                    if (ks + 2 < 12) { ka[(ks + 2) % 3][0] = *(const LAS bf16x8*)(Kb + 32 * (ks + 2)); ka[(ks + 2) % 3][1] = *(const LAS bf16x8*)(Kb + 32 * ML_KSTR + 32 * (ks + 2)); }
                    __builtin_amdgcn_sched_barrier(0);
                    p0 = __builtin_amdgcn_mfma_f32_32x32x16_bf16(ka[ks % 3][0], qf[ks], p0, 0, 0, 0);
                    p1 = __builtin_amdgcn_mfma_f32_32x32x16_bf16(ka[ks % 3][1], qf[ks], p1, 0, 0, 0);
                }
            }
            __builtin_amdgcn_s_setprio(0);
            if (k0 + 63 > qw) {
                const float NEG = -__builtin_inff();
#pragma unroll
                for (int r = 0; r < 16; ++r) { const int key = k0 + crow(r, hi); if (key > qrow) p0[r] = NEG; if (key + 32 > qrow) p1[r] = NEG; }
            }
        }
        if (gB && t + 1 < t_hi) ML_WRITE((t + 1) & 1);
        ML_BAR();
        if (gB && t + 2 < t_hi) ML_LOAD(t + 2);
        if (act) {
            const LAS unsigned char* Vb = lds + (t & 1) * ML_BUF + ML_KB + r32 * ML_VSTR + 16 * hi;
            float pmax = p0[0];
#pragma unroll
            for (int r = 1; r < 16; ++r) pmax = fmaxf(pmax, p0[r]);
#pragma unroll
            for (int r = 0; r < 16; ++r) pmax = fmaxf(pmax, p1[r]);
            pmax = half_swap_max(pmax);
            const float mn = fmaxf(m, pmax), alpha = __builtin_amdgcn_exp2f(m - mn);
            m = mn;
            float ps = 0.f;
#pragma unroll
            for (int r = 0; r < 16; ++r) { p0[r] = __builtin_amdgcn_exp2f(p0[r] - mn); p1[r] = __builtin_amdgcn_exp2f(p1[r] - mn); ps += p0[r] + p1[r]; }
            l = l * alpha + ps;
            if (!__all(alpha == 1.f)) {
#pragma unroll
                for (int d = 0; d < 4; ++d)
#pragma unroll
                    for (int r = 0; r < 16; ++r) o[d][r] *= alpha;
            }
            const bf16x8 pf0 = pack8(p0, 0), pf1 = pack8(p0, 8), pf2 = pack8(p1, 0), pf3 = pack8(p1, 8);
#pragma unroll
            for (int d = 0; d < 4; ++d) {
                const LAS unsigned char* vp = Vb + d * 32 * ML_VSTR;
                const bf16x8 v0 = *(const LAS bf16x8*)(vp), v1 = *(const LAS bf16x8*)(vp + 32), v2 = *(const LAS bf16x8*)(vp + 64), v3 = *(const LAS bf16x8*)(vp + 96);
                o[d] = __builtin_amdgcn_mfma_f32_32x32x16_bf16(v0, pf0, o[d], 0, 0, 0);
                o[d] = __builtin_amdgcn_mfma_f32_32x32x16_bf16(v1, pf1, o[d], 0, 0, 0);
                o[d] = __builtin_amdgcn_mfma_f32_32x32x16_bf16(v2, pf2, o[d], 0, 0, 0);
                o[d] = __builtin_amdgcn_mfma_f32_32x32x16_bf16(v3, pf3, o[d], 0, 0, 0);
            }
        }
        if (!gB && t + 1 < t_hi) ML_WRITE((t + 1) & 1);
        ML_BAR();
    }
    if (!gB) ML_BAR();
#undef ML_BAR
    const float lt = half_swap_sum(l);
    if (hi == 0) *(f32x2*)(ML + 2 * (32 * wave + r32)) = (f32x2){m, lt};
    float* yp = PO + (size_t)(32 * wave + r32) * 128 + 4 * hi;
#pragma unroll
    for (int d = 0; d < 4; ++d)
#pragma unroll
        for (int g = 0; g < 4; ++g) *(f32x4*)(yp + 32 * d + 8 * g) = (f32x4){o[d][4 * g], o[d][4 * g + 1], o[d][4 * g + 2], o[d][4 * g + 3]};
#undef ML_LOAD
#undef ML_WRITE
}

typedef short s16x4 __attribute__((ext_vector_type(4)));
constexpr int CU_P = 0, CU_M2 = 9216, CU_Q = 13824, CU_D2 = 22016, CU_BYTES = 26112;
constexpr int CL_RA = 0, CL_RB = 4608, CL_RK = 9216, CL_RR = 13824, CL_XA = 0, CL_XB = 5120, CL_XK = 10240, CL_XV = 15360, CL_T = 20480, CL_AAK = 24576, CL_ARB = 27136, CL_ARK = 29696, CL_WC = 32256, CL_BYTES = 32512;
DI unsigned short bf1(float x) { return (unsigned short)(pk2(x, 0.f) & 0xffffu); }
DI bf16x8 ld16(const LAS unsigned char* p) { return *(const LAS bf16x8*)p; }
DI bf16x8 ld8x2(const LAS unsigned char* p0, const LAS unsigned char* p1) { const s16x4 a = *(const LAS s16x4*)p0, b = *(const LAS s16x4*)p1; return __builtin_shufflevector(a, b, 0, 1, 2, 3, 4, 5, 6, 7); }
#define MFMA32(a, b, c) __builtin_amdgcn_mfma_f32_32x32x16_bf16((a), (b), (c), 0, 0, 0)
#define FR_RM(off, ks)        ld16(bR + (off) + 32 * (ks))
#define FR_X(off, rb, ks)     ld16(bX + (off) + (rb) * 80 + 32 * (ks))
#define FR_XP(off, rb, s)     ld8x2(bP + (off) + (rb) * 80 + 32 * (s), bP + (off) + (rb) * 80 + 32 * (s) + 16)
DI f32x16 zero16() { f32x16 z;
#pragma unroll
    for (int i = 0; i < 16; ++i) z[i] = 0.f;
    return z; }

DI void rwkv_chunk_unit(const unsigned* __restrict__ RKP, bf16* __restrict__ KP, const bf16* __restrict__ VB, const bf16* __restrict__ LOF,
                        const float* __restrict__ w0p, const float* __restrict__ a0p, const float* __restrict__ kkp, const float* __restrict__ kap,
                        unsigned char* __restrict__ CH, int u, LAS unsigned char* L, int lane_in) {
    int lane = lane_in; asm volatile("" : "+v"(lane));
    const int c = u >> 4, h = u & 15, l32 = lane & 31, hi = lane >> 5;
    unsigned char* rec = CH + (size_t)u * CU_BYTES;
    const LAS unsigned char* bR = L + l32 * 144 + 16 * hi; const LAS unsigned char* bX = L + l32 * 80 + 16 * hi; const LAS unsigned char* bP = L + l32 * 80 + 8 * hi; const LAS unsigned char* bU = L;
    LAS unsigned char* bW2 = L + 2 * lane; LAS unsigned char* bW80 = L + 80 * lane; LAS unsigned char* bS4 = L + 4 * l32 + 512 * hi; LAS unsigned char* bS2 = L + 2 * l32 + 320 * hi;
    asm volatile("" : "+v"(bR), "+v"(bX), "+v"(bP), "+v"(bU), "+v"(bW2), "+v"(bW80), "+v"(bS4), "+v"(bS2));
    v4u xa[4], xb[4], xk[4], xv[4];
    {
        const size_t g0 = (size_t)(32 * c) * 1024 + 64 * h + lane;
        const float w0c = w0p[64 * h + lane], a0c = a0p[64 * h + lane], kkc = kkp[64 * h + lane], kac = kap[64 * h + lane];
        float Lc = 0.f;
#pragma unroll
        for (int half = 0; half < 2; ++half) {
            unsigned rk_[16], vw_[16], wa_[16];
#pragma unroll
            for (int j = 0; j < 16; ++j) { const size_t off = g0 + (size_t)(16 * half + j) * 1024; const size_t lo = (size_t)(32 * c + 16 * half + j) * 3072 + 2 * (64 * h + lane);
                rk_[j] = RKP[off]; vw_[j] = *(const unsigned*)(VB + (off & ~(size_t)1)); wa_[j] = *(const unsigned*)(LOF + lo); }
            __builtin_amdgcn_sched_barrier(0);
#pragma unroll
            for (int tg2 = 0; tg2 < 2; ++tg2) {
                const int tg = 2 * half + tg2;
                float at[8], bt[8], kt[8];
#pragma unroll
                for (int j = 0; j < 8; ++j) {
                    const int t = 8 * tg + j, jj = 8 * tg2 + j;
                    const float lwl = -__expf(-softplus_f(-(w0c + bflo(wa_[jj]))) - 0.5f);
                    const float av_ = sigmoid_f(a0c + bfhi(wa_[jj]));
                    const float kraw = bfhi(rk_[jj]), kkr = kraw * kkc;
                    const float inv = 1.f / fmaxf(sqrtf(wave_sum(kkr * kkr)), 1e-12f);
                    const float kkn = kkr * inv, kpr = kraw * (1.f + (av_ - 1.f) * kac), bb = kkn * av_;
                    KP[g0 + (size_t)t * 1024] = bf1(kpr);
                    const float Lp = Lc; Lc += lwl;
                    const float e1 = __expf(Lc), e0 = __expf(Lp), ei = __expf(-Lc);
                    const float ra = bflo(rk_[jj]) * e1, aa = -kkn * e0, ba = bb * ei, ka = kpr * ei;
                    *(LAS unsigned short*)(bW2 + CL_RA + t * 144) = bf1(aa); *(LAS unsigned short*)(bW2 + CL_RB + t * 144) = bf1(ba);
                    *(LAS unsigned short*)(bW2 + CL_RK + t * 144) = bf1(ka); *(LAS unsigned short*)(bW2 + CL_RR + t * 144) = bf1(ra);
                    at[j] = aa; bt[j] = ba; kt[j] = ka;
                }
                v4u w;
                w.x = pk2(at[0], at[1]); w.y = pk2(at[2], at[3]); w.z = pk2(at[4], at[5]); w.w = pk2(at[6], at[7]); xa[tg] = w;
                w.x = pk2(bt[0], bt[1]); w.y = pk2(bt[2], bt[3]); w.z = pk2(bt[4], bt[5]); w.w = pk2(bt[6], bt[7]); xb[tg] = w;
                w.x = pk2(kt[0], kt[1]); w.y = pk2(kt[2], kt[3]); w.z = pk2(kt[4], kt[5]); w.w = pk2(kt[6], kt[7]); xk[tg] = w;
                { const unsigned sh = (lane & 1) ? 16u : 0u;
#define VSEL(i) ((vw_[8 * tg2 + (i)] >> sh) & 0xffffu)
                  w.x = VSEL(0) | (VSEL(1) << 16); w.y = VSEL(2) | (VSEL(3) << 16); w.z = VSEL(4) | (VSEL(5) << 16); w.w = VSEL(6) | (VSEL(7) << 16);
#undef VSEL
                }
                xv[tg] = w;
            }
            __builtin_amdgcn_sched_barrier(0);
        }
        *(LAS float*)(bW2 + 2 * lane + CL_WC) = __expf(Lc);
    }
    __builtin_amdgcn_sched_barrier(0);
    {
        f32x16 aab = zero16(), aak = zero16(), arb = zero16(), ark = zero16();
#pragma unroll
        for (int ks = 0; ks < 4; ++ks) {
            const bf16x8 fa = FR_RM(CL_RA, ks), fb = FR_RM(CL_RB, ks), fk = FR_RM(CL_RK, ks), fr = FR_RM(CL_RR, ks);
            aab = MFMA32(fa, fb, aab); aak = MFMA32(fa, fk, aak); arb = MFMA32(fr, fb, arb); ark = MFMA32(fr, fk, ark);
        }
#pragma unroll
        for (int r = 0; r < 16; ++r) {
            const int cr = (r & 3) + 8 * (r >> 2), t = cr + 4 * hi; const bool strict = t > l32, incl = t >= l32;
            *(LAS float*)(bS4 + CL_T + cr * 128) = strict ? aab[r] : 0.f;
            *(LAS unsigned short*)(bS2 + CL_AAK + cr * 80) = bf1(strict ? aak[r] : 0.f);
            *(LAS unsigned short*)(bS2 + CL_ARB + cr * 80) = bf1(incl ? arb[r] : 0.f);
            *(LAS unsigned short*)(bS2 + CL_ARK + cr * 80) = bf1(incl ? ark[r] : 0.f);
            __builtin_amdgcn_sched_barrier(0);
        }
    }
    s16x4 rinit[2][4];
#pragma unroll
    for (int mt = 0; mt < 2; ++mt)
#pragma unroll
        for (int g = 0; g < 4; ++g) rinit[mt][g] = *(const LAS s16x4*)(bR - 8 * hi + CL_RR + 2 * (32 * mt + 8 * g));
    __builtin_amdgcn_sched_barrier(0);
#pragma unroll
    for (int tg = 0; tg < 4; ++tg) { *(LAS v4u*)(bW80 + CL_XA + 16 * tg) = xa[tg]; *(LAS v4u*)(bW80 + CL_XB + 16 * tg) = xb[tg]; *(LAS v4u*)(bW80 + CL_XK + 16 * tg) = xk[tg]; *(LAS v4u*)(bW80 + CL_XV + 16 * tg) = xv[tg]; }
    __builtin_amdgcn_sched_barrier(0);
    {
        float x[32];
        const LAS unsigned char* bE = bU; const LAS unsigned char* bO = bU;
#pragma unroll
        for (int t = 0; t < 32; ++t) {
            float acc = (t == l32) ? 1.f : 0.f;
            const LAS unsigned char* bT = (t & 1) ? bO : bE;
#pragma unroll
            for (int q = 0; q < (t + 3) / 4; ++q) {
                const f32x4 a4 = *(const LAS f32x4*)(bT + CL_T + t * 128 + 16 * q);
#pragma unroll
                for (int e = 0; e < 4; ++e) if (4 * q + e < t) acc = fmaf(a4[e], x[4 * q + e], acc);
            }
            if (t & 1) asm volatile("" : "+v"(acc), "+v"(bO)); else asm volatile("" : "+v"(acc), "+v"(bE));
            x[t] = acc;
        }
#pragma unroll
        for (int t = 0; t < 32; ++t) *(LAS unsigned short*)(bS2 - 320 * hi + CL_T + t * 80) = bf1(x[t]);
    }
    __builtin_amdgcn_sched_barrier(0);
    f32x16 m1[2], d1[2];
#pragma unroll
    for (int nt = 0; nt < 2; ++nt) { m1[nt] = zero16();
#pragma unroll
        for (int ks = 0; ks < 2; ++ks) m1[nt] = MFMA32(FR_X(CL_T, 0, ks), FR_X(CL_XA, 32 * nt, ks), m1[nt]); }
    __builtin_amdgcn_sched_barrier(0);
#pragma unroll
    for (int nt = 0; nt < 2; ++nt) { f32x16 g = zero16();
#pragma unroll
        for (int ks = 0; ks < 2; ++ks) g = MFMA32(FR_X(CL_AAK, 0, ks), FR_X(CL_XV, 32 * nt, ks), g);
        d1[nt] = zero16();
        d1[nt] = MFMA32(FR_XP(CL_T, 0, 0), pack8(g, 0), d1[nt]); d1[nt] = MFMA32(FR_XP(CL_T, 0, 1), pack8(g, 8), d1[nt]); }
    __builtin_amdgcn_sched_barrier(0);
#pragma unroll
    for (int mt = 0; mt < 2; ++mt) {
        f32x16 z;
#pragma unroll
        for (int g = 0; g < 4; ++g) { const s16x4 rv = rinit[mt][g];
#pragma unroll
            for (int b = 0; b < 4; ++b) z[4 * g + b] = bf2f((unsigned)(unsigned short)rv[b]); }
        z = MFMA32(pack8(m1[mt], 0), FR_XP(CL_ARB, 0, 0), z); z = MFMA32(pack8(m1[mt], 8), FR_XP(CL_ARB, 0, 1), z);
#pragma unroll
        for (int g = 0; g < 4; ++g) { v2u w; w.x = pk2(z[4 * g], z[4 * g + 1]); w.y = pk2(z[4 * g + 2], z[4 * g + 3]);
            *(v2u*)(rec + CU_M2 + l32 * 144 + 2 * (16 * (2 * mt + (g >> 1)) + 8 * hi + 4 * (g & 1))) = w; }
        __builtin_amdgcn_sched_barrier(0);
    }
    __builtin_amdgcn_sched_barrier(0);
#pragma unroll
    for (int nt = 0; nt < 2; ++nt) {
        f32x16 z = zero16();
        z = MFMA32(FR_XP(CL_ARB, 0, 0), pack8(d1[nt], 0), z); z = MFMA32(FR_XP(CL_ARB, 0, 1), pack8(d1[nt], 8), z);
#pragma unroll
        for (int ks = 0; ks < 2; ++ks) z = MFMA32(FR_X(CL_ARK, 0, ks), FR_X(CL_XV, 32 * nt, ks), z);
#pragma unroll
        for (int g = 0; g < 4; ++g) { v2u w; w.x = pk2(z[4 * g], z[4 * g + 1]); w.y = pk2(z[4 * g + 2], z[4 * g + 3]); *(v2u*)(rec + CU_D2 + ((((nt * 4 + g) * 2 + hi) * 32 + l32) << 3)) = w; }
        __builtin_amdgcn_sched_barrier(0);
    }
    __builtin_amdgcn_sched_barrier(0);
#pragma unroll
    for (int nk = 0; nk < 2; ++nk) {
        const float wck = *(const LAS float*)(bS4 - 512 * hi + CL_WC + 128 * nk);
#pragma unroll
        for (int mt = 0; mt < 2; ++mt) {
            f32x16 z = zero16();
            z = MFMA32(pack8(m1[mt], 0), FR_XP(CL_XB, 32 * nk, 0), z); z = MFMA32(pack8(m1[mt], 8), FR_XP(CL_XB, 32 * nk, 1), z);
#pragma unroll
            for (int g = 0; g < 4; ++g) { float pv[4];
#pragma unroll
                for (int b = 0; b < 4; ++b) { const int k2 = 32 * mt + 8 * g + 4 * hi + b; pv[b] = (z[4 * g + b] + ((k2 == 32 * nk + l32) ? 1.f : 0.f)) * wck; }
                v2u w; w.x = pk2(pv[0], pv[1]); w.y = pk2(pv[2], pv[3]);
                *(v2u*)(rec + CU_P + (32 * nk + l32) * 144 + 2 * (16 * (2 * mt + (g >> 1)) + 8 * hi + 4 * (g & 1))) = w; }
            __builtin_amdgcn_sched_barrier(0);
        }
    }
    __builtin_amdgcn_sched_barrier(0);
#pragma unroll
    for (int nt = 0; nt < 2; ++nt)
#pragma unroll
        for (int mt = 0; mt < 2; ++mt) {
            f32x16 z = zero16();
            z = MFMA32(FR_XP(CL_XB, 32 * mt, 0), pack8(d1[nt], 0), z); z = MFMA32(FR_XP(CL_XB, 32 * mt, 1), pack8(d1[nt], 8), z);
#pragma unroll
            for (int ks = 0; ks < 2; ++ks) z = MFMA32(FR_X(CL_XK, 32 * mt, ks), FR_X(CL_XV, 32 * nt, ks), z);
#pragma unroll
            for (int g = 0; g < 4; ++g) { const f32x4 wc4 = *(const LAS f32x4*)(bP - 80 * l32 + 8 * hi + CL_WC + 4 * (32 * mt + 8 * g));
                v2u w; w.x = pk2(z[4 * g] * wc4[0], z[4 * g + 1] * wc4[1]); w.y = pk2(z[4 * g + 2] * wc4[2], z[4 * g + 3] * wc4[3]); *(v2u*)(rec + CU_Q + ((((((nt * 2 + mt) * 4 + g) * 2 + hi) * 32 + l32)) << 3)) = w; }
            __builtin_amdgcn_sched_barrier(0);
        }
}

constexpr int SQ_SLOT = 20480, SQ_D = 6  , SQ_NSLOT = SQ_D + 1, SQ_XOFF = SQ_SLOT * SQ_NSLOT, SQ_XBUF = 4096;
DI void rwkv_seq_wg(const unsigned char* __restrict__ CH, bf16* __restrict__ Y, int h, int vs, LAS unsigned char* lds, int tid) {
    const int lane = tid & 63, wave = __builtin_amdgcn_readfirstlane(tid >> 6), l32 = lane & 31, hi = lane >> 5;
    constexpr int NCH = S / 32;
    { unsigned zz = 0u; asm volatile("" : "+v"(zz));
      for (int i = tid; i < 2 * SQ_XBUF / 16; i += 512) *(LAS v4u*)(lds + SQ_XOFF + 16 * i) = (v4u){zz, zz, zz, zz}; }
    __syncthreads();
    if (wave >= 3) {
        const int lw = wave - 3;
        for (int c = 0; c < NCH + SQ_D; ++c) {
            if (c < NCH) {
                const unsigned char* rec = CH + (size_t)(c * 16 + h) * CU_BYTES;
#pragma unroll
                for (int i = 0; i < 4; ++i) {
                    const int pc = lw + 5 * i;
                    const int ob = pc * 1024 + lane * 16;
                    const unsigned char* src = ob < 13824 ? rec + ob : (ob < 17920 ? rec + CU_Q + vs * 4096 + (ob - 13824) : rec + CU_D2 + vs * 2048 + (ob - 17920));
                    if (ob >= 19968) src = rec;
                    __builtin_amdgcn_global_load_lds((const unsigned*)src, (LAS unsigned*)(lds + (c % SQ_NSLOT) * SQ_SLOT + pc * 1024), 16, 0, 0);
                }
            }
            static_assert(SQ_D == 6, "counted wait below");
            if (c < NCH) asm volatile("s_waitcnt vmcnt(20)" ::: "memory"); else asm volatile("s_waitcnt vmcnt(0)" ::: "memory");
            __builtin_amdgcn_s_barrier();
        }
    } else {
        for (int c = 0; c < NCH + SQ_D; ++c) {
            if (c >= SQ_D) {
                const int cc = c - SQ_D;
                const LAS unsigned char* B = lds + (cc % SQ_NSLOT) * SQ_SLOT;
                const LAS unsigned char* X = lds + SQ_XOFF + (cc & 1) * SQ_XBUF + lane * 16;
                const bf16x8 sb0 = ld16(X), sb1 = ld16(X + 1024), sb2 = ld16(X + 2048), sb3 = ld16(X + 3072);
                const LAS unsigned char* Am = B + (wave == 2 ? 9216 : wave * 32 * 144) + l32 * 144 + 16 * hi;
                const LAS unsigned char* Ci = B + (wave == 2 ? 17920 : 13824 + wave * 2048) + ((hi * 32 + l32) << 3);
                f32x16 n;
#pragma unroll
                for (int g = 0; g < 4; ++g) { const v2u q = *(const LAS v2u*)(Ci + g * 512);
                    n[4 * g] = bflo(q.x); n[4 * g + 1] = bfhi(q.x); n[4 * g + 2] = bflo(q.y); n[4 * g + 3] = bfhi(q.y); }
                n = MFMA32(ld16(Am), sb0, n); n = MFMA32(ld16(Am + 32), sb1, n); n = MFMA32(ld16(Am + 64), sb2, n); n = MFMA32(ld16(Am + 96), sb3, n);
                if (wave == 2) {
                    bf16* yp = Y + (size_t)(32 * cc) * 1024 + 64 * h + 32 * vs + l32;
#pragma unroll
                    for (int r = 0; r < 16; ++r) yp[(size_t)crow(r, hi) * 1024] = bf1(n[r]);
                } else {
                    LAS unsigned char* Xn = lds + SQ_XOFF + ((cc + 1) & 1) * SQ_XBUF + (2 * wave) * 1024 + lane * 16;
                    *(LAS bf16x8*)Xn = pack8(n, 0); *(LAS bf16x8*)(Xn + 1024) = pack8(n, 8);
                }
            }
            asm volatile("s_waitcnt lgkmcnt(0)" ::: "memory");
            __builtin_amdgcn_s_barrier();
        }
    }
}

constexpr int MQ_RW = 32, MQ_FULL = 192, MQ_LAST = 128, MQ_TOTAL = MQ_RW + MQ_FULL + MQ_LAST;
DI void mixers_phase(const KA& a, int l, int tid, LAS unsigned char* lds, int rep = 0) {
    unsigned char* ws = a.ws();
    unsigned* head = (unsigned*)(ws + WS_CTL) + CW_QUEUE + 64 * l + 1024 * rep;
    volatile LAS unsigned* slot = (volatile LAS unsigned*)(lds + MISC_OFF + 64);
    const int wave_s = __builtin_amdgcn_readfirstlane(tid >> 6);
    for (;;) {
        if (fresh_tid(wave_s) == 0) *slot = __hip_atomic_fetch_add(head, 1u, __ATOMIC_RELAXED, __HIP_MEMORY_SCOPE_AGENT);
        __syncthreads();
        const int it = (int)*slot;
        __syncthreads();
        if (it >= MQ_TOTAL) break;
        if (it < MQ_RW) {
            rwkv_seq_wg(ws + WS_CHK, (bf16*)(ws + WS_YRW), it >> 1, it & 1, lds, fresh_tid(wave_s));
        } else {
            int h, qb, j, i = it - MQ_RW;
            if (i < MQ_FULL) { h = i / 48; int r = i - 48 * h;
                if (r < 8) { qb = 8 + r; j = 0; } else if (r < 24) { r -= 8; qb = 16 + (r >> 1); j = r & 1; } else { r -= 24; qb = 24 + r / 3; j = r - 3 * (r / 3); } }
            else { i -= MQ_FULL; const int k = i >> 4, w = i & 15; h = w & 3; const int gq = w >> 2; qb = 8 * gq + 7 - k; j = gq; }
            const int t_lo = 32 * j, t_end = 4 * (qb + 1), t_hi = t_lo + 32 < t_end ? t_lo + 32 : t_end, ps = (h * 32 + qb) * 4 + j;
            mla_flash_unit((const bf16*)(ws + WS_QM), (const bf16*)(ws + WS_KM), (const bf16*)(ws + WS_VT), (float*)(ws + WS_PO) + (size_t)ps * 256 * 128, (float*)(ws + WS_PML) + (size_t)ps * 512,
                           h, qb, t_lo, t_hi, lds, fresh_tid(wave_s));
        }
        __syncthreads();
    }
}

DI void post_phase(const KA& a, int l, int gw, int ngw, int lane) {
    unsigned char* ws = a.ws();
    const bf16* YSB = (const bf16*)(ws + WS_YSB); const bf16* YRW = (const bf16*)(ws + WS_YRW);
    const unsigned* RKP = (const unsigned*)(ws + WS_RR); const bf16* RK = (const bf16*)(ws + WS_RW); const bf16* VB = (const bf16*)(ws + WS_RV); const bf16* LOFG = (const bf16*)(ws + WS_LOF) + 2048;
    bf16* CAT = (bf16*)(ws + WS_CAT);
    const float* sbn = a.in(I_SBN) + l * 512; const float* mlan = a.in(I_MLAN) + l * 512; const float* lnw = a.in(I_LNW) + l * 1024; const float* lnb = a.in(I_LNB) + l * 1024; const float* rk = a.in(I_RK) + l * 1024;
    for (int t = gw; t < S; t += ngw) {
        bf16* cat = CAT + (size_t)t * D;
#pragma unroll
        for (int part = 0; part < 2; ++part) {
            f32x4 y0, y1;
            if (part == 0) { const v4u w = *(const v4u*)(YSB + (size_t)t * 512 + 8 * lane); y0 = (f32x4){bflo(w.x), bfhi(w.x), bflo(w.y), bfhi(w.y)}; y1 = (f32x4){bflo(w.z), bfhi(w.z), bflo(w.w), bfhi(w.w)}; }
            else {
                const int hh = lane >> 4, qb = t >> 8, nch = (qb >> 3) + 1, ps0 = (hh * 32 + qb) * 4, rl = t & 255;
                const float* PO = (const float*)(ws + WS_PO); const float* PML = (const float*)(ws + WS_PML);
                float mj[4], lj[4], M = -1e30f;
#pragma unroll
                for (int j = 0; j < 4; ++j) { mj[j] = -1e30f; lj[j] = 0.f; if (j < nch) { const f32x2 v = *(const f32x2*)(PML + (size_t)(ps0 + j) * 512 + 2 * rl); mj[j] = v.x; lj[j] = v.y; M = fmaxf(M, v.x); } }
                float Ls = 0.f; y0 = (f32x4){0.f, 0.f, 0.f, 0.f}; y1 = y0;
#pragma unroll
                for (int j = 0; j < 4; ++j) if (j < nch) { const float wj = __builtin_amdgcn_exp2f(mj[j] - M); Ls += lj[j] * wj;
                    const float* po = PO + ((size_t)(ps0 + j) * 256 + rl) * 128 + 8 * (lane & 15); y0 = y0 + *(const f32x4*)po * wj; y1 = y1 + *(const f32x4*)(po + 4) * wj; }
                const float il = 1.f / Ls; y0 = y0 * il; y1 = y1 * il;
            }
            const float* g = (part ? mlan : sbn) + 8 * lane;
            const f32x4 g0 = *(const f32x4*)g, g1 = *(const f32x4*)(g + 4);
            float s = (y0.x * y0.x + y0.y * y0.y) + (y0.z * y0.z + y0.w * y0.w) + (y1.x * y1.x + y1.y * y1.y) + (y1.z * y1.z + y1.w * y1.w);
            s = grp_sum<16>(s);
            const float rstd = 1.f / sqrtf(s * (1.f / 128.f) + EPS);
            v4u w; w.x = pk2(y0.x * rstd * g0.x, y0.y * rstd * g0.y); w.y = pk2(y0.z * rstd * g0.z, y0.w * rstd * g0.w); w.z = pk2(y1.x * rstd * g1.x, y1.y * rstd * g1.y); w.w = pk2(y1.z * rstd * g1.z, y1.w * rstd * g1.w);
            *(v4u*)(cat + 512 * part + 8 * lane) = w;
        }
        const size_t ro = (size_t)t * 1024 + 16 * lane;
        float y[16], sum = 0.f, bon = 0.f;
#pragma unroll
        for (int j = 0; j < 4; ++j) { const f32x4 yy = ldz4(YRW + ro + 4 * j), k4 = ldz4(RK + ro + 4 * j), rk4 = *(const f32x4*)(rk + 16 * lane + 4 * j);
            const v4u rp = *(const v4u*)(RKP + ro + 4 * j); const f32x4 r4 = {bflo(rp.x), bflo(rp.y), bflo(rp.z), bflo(rp.w)};
#pragma unroll
            for (int e = 0; e < 4; ++e) { y[4 * j + e] = yy[e]; sum += yy[e]; bon += r4[e] * k4[e] * rk4[e]; } }
        sum = grp_sum<4>(sum); bon = grp_sum<4>(bon);
        const float mean = sum * (1.f / 64.f); float var = 0.f;
#pragma unroll
        for (int i = 0; i < 16; ++i) { y[i] -= mean; var += y[i] * y[i]; }
        var = grp_sum<4>(var) * (1.f / 64.f);
        const float rstd = 1.f / sqrtf(var + 64e-5f);
#pragma unroll
        for (int j = 0; j < 2; ++j) {
            float ov[8];
            const v4u gp = *(const v4u*)(LOFG + (size_t)t * 3072 + 16 * lane + 8 * j); const float gt[8] = {bflo(gp.x), bfhi(gp.x), bflo(gp.y), bfhi(gp.y), bflo(gp.z), bfhi(gp.z), bflo(gp.w), bfhi(gp.w)};
            const v4u vp = *(const v4u*)(VB + ro + 8 * j); const float vt[8] = {bflo(vp.x), bfhi(vp.x), bflo(vp.y), bfhi(vp.y), bflo(vp.z), bfhi(vp.z), bflo(vp.w), bfhi(vp.w)};
#pragma unroll
            for (int e = 0; e < 8; ++e) { const int i = 8 * j + e, c = 16 * lane + i;
                ov[e] = (y[i] * rstd * lnw[c] + lnb[c] + bon * vt[e]) * gt[e];
            }
            v4u w; w.x = pk2(ov[0], ov[1]); w.y = pk2(ov[2], ov[3]); w.z = pk2(ov[4], ov[5]); w.w = pk2(ov[6], ov[7]);
            *(v4u*)(cat + 1024 + 16 * lane + 8 * j) = w;
        }
    }
}

constexpr int N_PHASES = NL * (1 + 2 + 7 + 2) + 1;
__global__ void __launch_bounds__(NWAVES * 64, 2) hybrid_fwd(Args args) {
    extern __shared__ __attribute__((aligned(16))) unsigned char lds_raw[];
    LAS unsigned char* lds = (LAS unsigned char*)lds_raw;
    const int tid = threadIdx.x;
    const int G_k = gridDim.x, bid_k = blockIdx.x, wave_k = __builtin_amdgcn_readfirstlane(tid >> 6);
    volatile LAS unsigned* MISC = (volatile LAS unsigned*)(lds + MISC_OFF);
#if MK_SINGLE
    for (int u = tid; u < (LDS_BYTES - MISC_OFF) / 4; u += NWAVES * 64) ((LAS unsigned*)(lds + MISC_OFF))[u] = 0u;
    __syncthreads();
    XcdBarrier bar = xcd_barrier_post((unsigned*)(args.ws + WS_CTL) + CW_BAR, MISC + 8);
#define GRID_BAR() xcd_barrier(bar, fresh_tid(wave_p))
#else
#define GRID_BAR() do {} while (0)
#endif
    const int lo = args.ph_lo, hi = args.ph_hi;
    int ph = 0;
#define PHASE_BEGIN if (ph >= lo && ph < hi) { int wave_p = wave_k; asm volatile("" : "+s"(wave_p)); int lane_p; \
        asm volatile("v_mbcnt_lo_u32_b32 %0, -1, 0\n\tv_mbcnt_hi_u32_b32 %0, -1, %0" : "=v"(lane_p)); const int tid_p = (wave_p << 6) | lane_p; \
        kaptr_t ka_p = (kaptr_t)__builtin_amdgcn_kernarg_segment_ptr(); asm volatile("" : "+s"(ka_p)); const KA a{ka_p}; unsigned char* ws = a.ws(); \
        int G = G_k, bid = bid_k; asm volatile("" : "+s"(G), "+s"(bid)); const int ngw = G * NWAVES; (void)ngw; \
        const int lane = lane_p, wave = wave_p, gw = bid * NWAVES + wave, wi = wave * G + bid; (void)lane; (void)gw; (void)wi; (void)ws;
#define PHASE_END   if (ph + 1 < hi) GRID_BAR(); } ++ph;

#pragma unroll
    for (int l = 0; l < NL; ++l) {
        const size_t WB = (l & 1) ? WB_DELTA : 0;
        PHASE_BEGIN if (l == 0) { conv_phase(a, 0, lds, gw, ngw, wave, lane); __syncthreads(); } else conv_harvest(a, l, -1, G, tid_p, lds);
        PHASE_END
#pragma unroll
        for (int f = 0; f < 2; ++f) {
            PHASE_BEGIN {
                pg8::Gemm g{(const pg8::bf16_t*)(ws + WS_XB), (const pg8::bf16_t*)(ws + WB + (f ? W_GU1 : W_GU0)), S, 2 * FF, D}; pg8::StaticOrder So; So.init(S, 2 * FF, G, bid);
                rstd_table(So, (const float*)(ws + WS_PART), (LAS _Float16*)(lds + RING_BYTES + 8192), fresh_tid(wave_p));
                pg8::EpiSwiglu E{(pg8::bf16_t*)(ws + WS_H), FF, (const LAS _Float16*)(lds + RING_BYTES + 8192)};
                pg8::gemm_phase<pg8::EpiSwiglu, pg8::StaticOrder, true, true>(lds, g, So, E, fresh_tid(wave_p));
                if (l + 1 < NL) conv_harvest(a, l + 1, ph, G, fresh_tid(wave_p), lds); } PHASE_END
            PHASE_BEGIN {
                pg8::Gemm g{(const pg8::bf16_t*)(ws + WS_H), (const pg8::bf16_t*)(ws + WB + (f ? W_DN1 : W_DN0)), S, D, FF}; pg8::StaticOrder So; So.init(S, D, G, bid);
                pg8::EpiResid E{(pg8::bf16_t*)(ws + WS_XB), D, 0.5f, (float*)(ws + WS_PART), (LAS float*)(lds + RING_BYTES + 1024)};
                pg8::gemm_phase<pg8::EpiResid, pg8::StaticOrder, true, true>(lds, g, So, E, fresh_tid(wave_p)); } PHASE_END
            if (f == 0) {
                PHASE_BEGIN {
                    pg8::Gemm g{(const pg8::bf16_t*)(ws + WS_XB), (const pg8::bf16_t*)(ws + WB + W_IN), S, ZC, D}; pg8::StaticOrder So; So.init(S, ZC, G, bid);
                    rstd_table(So, (const float*)(ws + WS_PART), (LAS _Float16*)(lds + RING_BYTES + 8192), fresh_tid(wave_p));
                    pg8::EpiBf16 E{(pg8::bf16_t*)(ws + WS_Z), ZC, (const LAS _Float16*)(lds + RING_BYTES + 8192)};
                    pg8::gemm_phase<pg8::EpiBf16, pg8::StaticOrder, true, true>(lds, g, So, E, fresh_tid(wave_p));
                    if (l + 1 < NL) conv_harvest(a, l + 1, ph, G, fresh_tid(wave_p), lds); } PHASE_END
                PHASE_BEGIN prep1_phase(a, l, gw, ngw, lane);
                PHASE_END
                PHASE_BEGIN {
                    { pg8::Gemm g{(const pg8::bf16_t*)(ws + WS_CQN), (const pg8::bf16_t*)(ws + WB + W_UQ), S, 768, 512}; pg8::StaticOrder So; So.init(S, 768, G, bid);
                      pg8::EpiQM E{ws};
                      pg8::gemm_phase<pg8::EpiQM, pg8::StaticOrder, true, true>(lds, g, So, E, fresh_tid(wave_p)); }
                    { pg8::Gemm g{(const pg8::bf16_t*)(ws + WS_CKVN), (const pg8::bf16_t*)(ws + WB + W_UKV), S, 512, 256}; pg8::StaticOrder So; So.init(S, 512, G, (bid + G - 96 % G) % G);
                      pg8::EpiKM E{ws}; pg8::gemm_phase<pg8::EpiKM, pg8::StaticOrder, true, true>(lds, g, So, E, fresh_tid(wave_p)); }
                    { pg8::Gemm g{(const pg8::bf16_t*)(ws + WB + W_UKVV), (const pg8::bf16_t*)(ws + WS_CKVN), 512, S, 256}; pg8::StaticOrder So; So.init(512, S, G, (bid + G - 160 % G) % G);
                      pg8::EpiVT E{(pg8::bf16_t*)(ws + WS_VT), S}; pg8::gemm_phase<pg8::EpiVT, pg8::StaticOrder, true, true>(lds, g, So, E, fresh_tid(wave_p)); }
                    { pg8::Gemm g{(const pg8::bf16_t*)(ws + WS_LORAA), (const pg8::bf16_t*)(ws + WB + W_LORA), S, 3072, 256}; pg8::StaticOrder So; So.init(S, 3072, G, (bid + G - 96 % G) % G);
                      pg8::EpiBf16 E{(pg8::bf16_t*)(ws + WS_LOF), 3072, nullptr}; pg8::gemm_phase<pg8::EpiBf16, pg8::StaticOrder, true, true>(lds, g, So, E, fresh_tid(wave_p)); }
                    if (l + 1 < NL) conv_harvest(a, l + 1, ph, G, fresh_tid(wave_p), lds); } PHASE_END
                PHASE_BEGIN {
                    if (wave < 4) { for (int u = bid * 4 + wave; u < 4096; u += G * 4)
                        rwkv_chunk_unit((const unsigned*)(ws + WS_RR), (bf16*)(ws + WS_RW), (const bf16*)(ws + WS_RV), (const bf16*)(ws + WS_LOF),
                                        a.in(I_W0) + l * 1024, a.in(I_A0) + l * 1024, a.in(I_KK) + l * 1024, a.in(I_KA) + l * 1024, ws + WS_CHK, u, lds + wave * CL_BYTES, lane); }
                    else { prep2_phase(a, l, bid * 4 + (wave - 4), G * 4, lane);
                        for (int u0 = bid * 4 + (wave - 4); u0 < 1024; u0 += G * 4) {
#pragma unroll 1
                            for (int r2 = 0; r2 < 2; ++r2) { const int sbi = r2 ? 2047 - u0 : u0;
                                sb_item<3, 4>((const bf16*)(ws + WS_Z) + ZC_SBQ, (const bf16*)(ws + WS_Z) + ZC_SBK, (const bf16*)(ws + WS_Z) + ZC_SBV, (bf16*)(ws + WS_YSB), sbi >> 9, sbi & 511, lane,
                                              lds + 4 * CL_BYTES + (wave - 4) * 8192); } } } } PHASE_END
                PHASE_BEGIN mixers_phase(a, l, tid_p, lds); if (l + 1 < NL) conv_harvest(a, l + 1, ph, G, fresh_tid(wave_p), lds);
                PHASE_END
                PHASE_BEGIN post_phase(a, l, gw, ngw, lane);
                PHASE_END
                PHASE_BEGIN {
                    pg8::Gemm g{(const pg8::bf16_t*)(ws + WS_CAT), (const pg8::bf16_t*)(ws + WB + W_OUT), S, D, D}; pg8::StaticOrder So; So.init(S, D, G, bid);
                    pg8::EpiResid E{(pg8::bf16_t*)(ws + WS_XB), D, 1.0f, (float*)(ws + WS_PART), (LAS float*)(lds + RING_BYTES + 1024)};
                    pg8::gemm_phase<pg8::EpiResid, pg8::StaticOrder, true, true>(lds, g, So, E, fresh_tid(wave_p)); } PHASE_END
            }
        }
    }
    PHASE_BEGIN final_phase((const bf16*)(ws + WS_XB), a.out(), a.in(I_FN), gw, ngw, lane); PHASE_END
}

extern "C" void kernel_launch(void* const* d_in, const int* in_sizes, int n_in, void* d_out, int out_size, void* d_ws, size_t ws_size, hipStream_t stream) {
    static int grid = 0;
    if (grid == 0) {
        if (n_in != N_IN || in_sizes[0] != S * D || out_size != S * D || ws_size < WS_END) {
            fprintf(stderr, "kernel_launch: shape/workspace mismatch (n_in %d, in0 %d, out %d, ws %zu, need %zu); nothing launched\n", n_in, n_in > 0 ? in_sizes[0] : -1, out_size, ws_size, (size_t)WS_END); grid = -1; return; }
        int dev = 0, cus = 0, per_cu = 0;
        if (hipGetDevice(&dev) != hipSuccess || hipDeviceGetAttribute(&cus, hipDeviceAttributeMultiprocessorCount, dev) != hipSuccess) { grid = -1; return; }
        if (hipFuncSetAttribute((const void*)hybrid_fwd, hipFuncAttributeMaxDynamicSharedMemorySize, LDS_BYTES) != hipSuccess) { fprintf(stderr, "kernel_launch: hipFuncSetAttribute failed\n"); grid = -1; return; }
        if (hipOccupancyMaxActiveBlocksPerMultiprocessor(&per_cu, (const void*)hybrid_fwd, NWAVES * 64, LDS_BYTES) != hipSuccess || per_cu < 1)
            fprintf(stderr, "kernel_launch: note: occupancy query reports %d workgroups per CU\n", per_cu);
        (void)hipGetLastError();
        grid = cus;
    }
    if (grid < 0) return;
    (void)hipMemsetAsync((char*)d_ws + WS_CTL, 0, CTL_ZERO_BYTES, stream);
    Args a{};
    for (int i = 0; i < N_IN; ++i) a.in[i] = (const float*)d_in[i];
    a.out = (float*)d_out; a.ws = (unsigned char*)d_ws;
#if MK_SINGLE
    a.ph_lo = 0; a.ph_hi = N_PHASES;
    hipLaunchKernelGGL(hybrid_fwd, dim3(grid), dim3(NWAVES * 64), LDS_BYTES, stream, a);
#else
    for (int p = 0; p < N_PHASES; ++p) { a.ph_lo = p; a.ph_hi = p + 1; hipLaunchKernelGGL(hybrid_fwd, dim3(grid), dim3(NWAVES * 64), LDS_BYTES, stream, a); }
#endif
}
```

```cpp
#include <hip/hip_runtime.h>
#include <cstdio>
#include <cstdint>
#define LAS __attribute__((address_space(3)))
#define GAS __attribute__((address_space(1)))

#define MK_SINGLE 1
namespace pg8 {
#define PG8_LAS __attribute__((address_space(3)))
typedef unsigned short bf16_t;
typedef short bf16x8 __attribute__((ext_vector_type(8)));
typedef float f32x4 __attribute__((ext_vector_type(4)));
typedef unsigned u32x4 __attribute__((ext_vector_type(4)));
constexpr int BM = 256, BK = 64, HALF = 128, HTB = HALF * BK * 2  , STAGE_BYTES = 8 * HTB, NXCD = 8, WGM = 8;

__host__ __device__ __forceinline__ int lds_byte(int r, int c) { const int st = (r >> 4) * 2 + (c >> 5), rr = r & 15, cc = c & 31, ob = rr * 64 + cc * 2; return st * 1024 + (ob ^ (((ob >> 9) & 1) << 5)); }
__host__ __device__ __forceinline__ void stage_rc(int b, int& R, int& C) { const int st = b / 1024, sb = b % 1024, swz = sb ^ (((sb >> 9) & 1) << 5); R = (st >> 1) * 16 + swz / 64; C = (st & 1) * 32 + (swz % 64) / 2; }
__host__ __device__ __forceinline__ int perm32(int rho) { const int n = rho >> 4, i = rho & 15; return 8 * (i >> 2) + 4 * n + (i & 3); }

struct Unit { int pm, pn; };
struct Gemm { const bf16_t* A; const bf16_t* Bt; int M, N, K; };

struct StaticOrder {
    int nM, nN, nwg, G, c;
    __host__ __device__ void init(int M, int N, int G_, int c_) { nM = M / BM; nN = N / BM; nwg = nM * nN; G = G_; c = c_; }
    __host__ __device__ bool next(int i, Unit& u) const {
        const long L = (long)i * G + c; if (L >= nwg) return false;
        int wgid = (int)L; { const int q = nwg / NXCD, r = nwg % NXCD, xcd = wgid % NXCD, off = wgid / NXCD; wgid = (xcd < r ? xcd * (q + 1) : r * (q + 1) + (xcd - r) * q) + off; }
        const int nig = WGM * nN, gid = wgid / nig, fm = gid * WGM, gsz = (nM - fm) < WGM ? (nM - fm) : WGM;
        u.pm = fm + ((wgid % nig) % gsz); u.pn = (wgid % nig) / gsz; return true;
    }
    __device__ __forceinline__ void a_ready(const Unit&) const {}
    __device__ __forceinline__ void done(const Unit&) const {}
};

template <class Epi, class Sched, bool ALIGN_EPI = false, bool SP2 = false>
__device__ __forceinline__ void gemm_phase(PG8_LAS unsigned char* lds, const Gemm g, const Sched& S, const Epi& E, int tid_in) {
    int tid_o = tid_in; asm volatile("" : "+v"(tid_o));
    const int tid = tid_o, wid = __builtin_amdgcn_readfirstlane(tid >> 6), lane = tid & 63, wr = wid >> 2, wc = wid & 3, fr = lane & 15, fq = lane >> 4;
    const int K = g.K, nt = K / BK;
    unsigned voffA[2], voffB[2];
#pragma unroll
    for (int i = 0; i < 2; ++i) { int R, C; stage_rc(tid * 16 + i * 8192, R, C); const int Rb = Epi::PERM ? ((R & ~31) + perm32(R & 31)) : R;
        voffA[i] = (unsigned)(R * K + C) * 2u; voffB[i] = (unsigned)(Rb * K + C) * 2u; }
    const size_t kstep = (size_t)(BK * 2);
    const size_t hstep = (size_t)HALF * K * 2;
    const size_t tstep = 2 * hstep;
    const unsigned ldsw = (unsigned)wid * 1024u;
    const int aoff = lds_byte(wr * 64 + fr, fq * 8), boff = lds_byte(wc * 32 + fr, fq * 8);
#define PG8_SA(b, h) (((b) * 2 + (h)) * HTB)
#define PG8_SB(b, h) ((4 + (b) * 2 + (h)) * HTB)
#define PG8_STAGE(bufoff, gbase, voff) do { _Pragma("unroll") for (int _i = 0; _i < 2; ++_i) \
        __builtin_amdgcn_global_load_lds((const unsigned*)((const char*)(gbase) + (voff)[_i]), (PG8_LAS unsigned*)(lds + (bufoff) + ldsw + _i * 8192), 16, 0, 0); } while (0)
#define PG8_LDA(dst, b, h) do { _Pragma("unroll") for (int m = 0; m < 4; ++m) _Pragma("unroll") for (int k = 0; k < 2; ++k) dst[m][k] = *(const PG8_LAS bf16x8*)(lds + PG8_SA(b, h) + aoff + m * 2048 + k * 1024); } while (0)
#define PG8_LDB(dst, b, h) do { _Pragma("unroll") for (int n = 0; n < 2; ++n) _Pragma("unroll") for (int k = 0; k < 2; ++k) dst[n][k] = *(const PG8_LAS bf16x8*)(lds + PG8_SB(b, h) + boff + n * 2048 + k * 1024); } while (0)
#define PG8_MMA(ai, bj, At, Bt) do { __builtin_amdgcn_s_setprio(1); _Pragma("unroll") for (int m = 0; m < 4; ++m) _Pragma("unroll") for (int n = 0; n < 2; ++n) _Pragma("unroll") for (int k = 0; k < 2; ++k) \
        acc[ai][bj][m][n] = __builtin_amdgcn_mfma_f32_16x16x32_bf16(Bt[n][k], At[m][k], acc[ai][bj][m][n], 0, 0, 0); __builtin_amdgcn_s_setprio(0); } while (0)
#define PG8_WAIT_V(n) asm volatile("s_waitcnt vmcnt(" #n ")" ::: "memory")
#define PG8_WAIT_L(n) asm volatile("s_waitcnt lgkmcnt(" #n ")" ::: "memory")
#define PG8_BAR __builtin_amdgcn_s_barrier()
#define PG8_SCHED __builtin_amdgcn_sched_barrier(0)
    Unit cur, nxt; int ui = 0;
    if (!S.next(0, cur)) return;
    f32x4 acc[2][2][4][2];
#pragma unroll
    for (int a = 0; a < 2; ++a)
#pragma unroll
        for (int b = 0; b < 2; ++b)
#pragma unroll
            for (int m = 0; m < 4; ++m)
#pragma unroll
                for (int n = 0; n < 2; ++n) acc[a][b][m][n] = (f32x4){0.f, 0.f, 0.f, 0.f};
    bf16x8 At[4][2], B0[2][2], B1[2][2];
    const char* cA = (const char*)g.A + (size_t)cur.pm * tstep; const char* cB = (const char*)g.Bt + (size_t)cur.pn * tstep;
    S.a_ready(cur);
    if constexpr (SP2) {
        PG8_STAGE(PG8_SB(0, 0), cB, voffB); PG8_STAGE(PG8_SB(0, 1), cB + hstep, voffB); PG8_STAGE(PG8_SA(0, 0), cA, voffA); PG8_STAGE(PG8_SA(0, 1), cA + hstep, voffA);
        if (wr == 1) PG8_BAR;
        PG8_WAIT_V(2); PG8_BAR;
        PG8_STAGE(PG8_SB(1, 0), cB + kstep, voffB); PG8_STAGE(PG8_SA(1, 0), cA + kstep, voffA); PG8_STAGE(PG8_SB(1, 1), cB + hstep + kstep, voffB);
        PG8_WAIT_V(6); PG8_BAR;
    } else {
        PG8_STAGE(PG8_SB(0, 0), cB, voffB); PG8_STAGE(PG8_SA(0, 0), cA, voffA); PG8_STAGE(PG8_SB(0, 1), cB + hstep, voffB); PG8_STAGE(PG8_SA(0, 1), cA + hstep, voffA);
        if (wr == 1) PG8_BAR;
        PG8_WAIT_V(4); PG8_BAR;
        PG8_STAGE(PG8_SB(1, 0), cB + kstep, voffB); PG8_STAGE(PG8_SA(1, 0), cA + kstep, voffA); PG8_STAGE(PG8_SB(1, 1), cB + hstep + kstep, voffB);
        PG8_WAIT_V(6); PG8_BAR;
    }
    for (;;) {
        const bool has_next = S.next(ui + 1, nxt);
        const char* nA = has_next ? (const char*)g.A + (size_t)nxt.pm * tstep : cA; const char* nB = has_next ? (const char*)g.Bt + (size_t)nxt.pn * tstep : cB;
        for (int t = 0; t < nt; t += 2) {
            const bool last = (t == nt - 2);
            const char* a1 = cA + (size_t)(t + 1) * kstep;
            const char* a2 = last ? nA : cA + (size_t)(t + 2) * kstep; const char* b2 = last ? nB : cB + (size_t)(t + 2) * kstep;
            const char* a3 = a2 + kstep; const char* b3 = b2 + kstep;
            if (last && has_next) S.a_ready(nxt);
            if constexpr (SP2) {
            PG8_LDB(B0, 0, 0); PG8_LDB(B1, 0, 1); PG8_SCHED; PG8_LDA(At, 0, 0); PG8_STAGE(PG8_SA(1, 1), a1 + hstep, voffA);
            PG8_WAIT_V(8); PG8_WAIT_L(0); PG8_BAR; PG8_MMA(0, 0, At, B0); PG8_MMA(0, 1, At, B1); PG8_BAR; PG8_SCHED;
            PG8_LDA(At, 0, 1); PG8_STAGE(PG8_SB(0, 0), b2, voffB); PG8_STAGE(PG8_SB(0, 1), b2 + hstep, voffB); PG8_STAGE(PG8_SA(0, 0), a2, voffA);
            PG8_WAIT_V(8); PG8_WAIT_L(0); PG8_BAR; PG8_MMA(1, 0, At, B0); PG8_MMA(1, 1, At, B1); PG8_BAR; PG8_SCHED;
            PG8_LDB(B0, 1, 0); PG8_LDB(B1, 1, 1); PG8_SCHED; PG8_LDA(At, 1, 0); PG8_STAGE(PG8_SA(0, 1), a2 + hstep, voffA);
            PG8_WAIT_V(8); PG8_WAIT_L(0); PG8_BAR; PG8_MMA(0, 0, At, B0); PG8_MMA(0, 1, At, B1); PG8_BAR; PG8_SCHED;
            PG8_LDA(At, 1, 1); PG8_STAGE(PG8_SB(1, 0), b3, voffB); PG8_STAGE(PG8_SB(1, 1), b3 + hstep, voffB); PG8_STAGE(PG8_SA(1, 0), a3, voffA);
            PG8_WAIT_V(8); PG8_WAIT_L(0); PG8_BAR; PG8_MMA(1, 0, At, B0); PG8_MMA(1, 1, At, B1); PG8_BAR; PG8_SCHED;
            } else {
            PG8_LDB(B0, 0, 0); PG8_SCHED; PG8_LDA(At, 0, 0); PG8_STAGE(PG8_SA(1, 1), a1 + hstep, voffA);
            PG8_WAIT_L(8); PG8_BAR; PG8_WAIT_L(0); PG8_MMA(0, 0, At, B0); PG8_BAR; PG8_SCHED;
            PG8_LDB(B1, 0, 1); PG8_STAGE(PG8_SB(0, 0), b2, voffB);
            PG8_BAR; PG8_WAIT_L(0); PG8_MMA(0, 1, At, B1); PG8_BAR;
            PG8_LDA(At, 0, 1); PG8_STAGE(PG8_SA(0, 0), a2, voffA);
            PG8_BAR; PG8_WAIT_L(0); PG8_MMA(1, 0, At, B0); PG8_BAR; PG8_SCHED;
            PG8_STAGE(PG8_SB(0, 1), b2 + hstep, voffB);
            PG8_WAIT_V(6); PG8_BAR; PG8_MMA(1, 1, At, B1); PG8_BAR;
            PG8_LDB(B0, 1, 0); PG8_SCHED; PG8_LDA(At, 1, 0); PG8_STAGE(PG8_SA(0, 1), a2 + hstep, voffA);
            PG8_WAIT_L(8); PG8_BAR; PG8_WAIT_L(0); PG8_MMA(0, 0, At, B0); PG8_BAR; PG8_SCHED;
            PG8_LDB(B1, 1, 1); PG8_STAGE(PG8_SB(1, 0), b3, voffB);
            PG8_BAR; PG8_WAIT_L(0); PG8_MMA(0, 1, At, B1); PG8_BAR;
            PG8_LDA(At, 1, 1); PG8_STAGE(PG8_SA(1, 0), a3, voffA);
            PG8_BAR; PG8_WAIT_L(0); PG8_MMA(1, 0, At, B0); PG8_BAR; PG8_SCHED;
            PG8_STAGE(PG8_SB(1, 1), b3 + hstep, voffB);
            PG8_WAIT_V(6); PG8_BAR; PG8_MMA(1, 1, At, B1); PG8_BAR;
            }
        }
        if constexpr (ALIGN_EPI) { if (wr == 0) PG8_BAR; }
        if constexpr (!Epi::AFTER_DRAIN) {
            int le_; asm volatile("v_mbcnt_lo_u32_b32 %0, -1, 0\n\tv_mbcnt_hi_u32_b32 %0, -1, %0" : "=v"(le_));
            E(acc, cur, wr, wc, le_ & 15, le_ >> 4); S.done(cur); }
        if (!has_next) break;
#pragma unroll
        for (int a = 0; a < 2; ++a)
#pragma unroll
            for (int b = 0; b < 2; ++b)
#pragma unroll
                for (int m = 0; m < 4; ++m)
#pragma unroll
                    for (int n = 0; n < 2; ++n) acc[a][b][m][n] = (f32x4){0.f, 0.f, 0.f, 0.f};
        cur = nxt; cA = nA; cB = nB; ++ui;
        if constexpr (ALIGN_EPI) { if (wr == 1) PG8_BAR; }
    }
    PG8_WAIT_V(0);
    if constexpr (!ALIGN_EPI) { if (wr == 0) PG8_BAR; }
    PG8_BAR;
    if constexpr (Epi::AFTER_DRAIN) { E.fused(acc, cur, wr, wc, fr, fq, lds, wid, lane); S.done(cur); }
#undef PG8_SA
#undef PG8_SB
#undef PG8_STAGE
#undef PG8_LDA
#undef PG8_LDB
#undef PG8_MMA
#undef PG8_WAIT_V
#undef PG8_WAIT_L
#undef PG8_BAR
#undef PG8_SCHED
}
}
#define XB_TMO      128
#define XB_XCNT(j)  (256  + 64 * (j))
#define XB_XSUB(j)  (1280 + 64 * (j))
#define XB_XGEN(j)  (2304 + 64 * (j))
#define XB_TOP      3328
#define XB_TOPGEN   3392
#define XCD_BAR_WORDS 3456
#define XB_SPIN_CAP (1u << 22)

__device__ __forceinline__ unsigned xb_ld(unsigned* p)              { return __hip_atomic_load(p, __ATOMIC_RELAXED, __HIP_MEMORY_SCOPE_AGENT); }
__device__ __forceinline__ unsigned xb_add(unsigned* p, unsigned v) { return __hip_atomic_fetch_add(p, v, __ATOMIC_RELAXED, __HIP_MEMORY_SCOPE_AGENT); }
__device__ __forceinline__ unsigned xb_xcc_id() { return (unsigned)__builtin_amdgcn_s_getreg((3 << 11) | 20) & 0xFu; }
#define XB_SPIN(cond, bar) do { unsigned _sp = 0; while (cond) { __builtin_amdgcn_s_sleep(1); \
    if ((++_sp & 255u) == 0u) { if (xb_ld(&(bar)[XB_TMO])) break; if (_sp > XB_SPIN_CAP) { atomicAdd(&(bar)[XB_TMO], 1u); break; } } } } while (0)

struct XcdBarrier {
    unsigned* bar; unsigned x;
    volatile LAS unsigned* st;
};

__device__ __forceinline__ XcdBarrier xcd_barrier_post(unsigned* bar, volatile LAS unsigned* st) {
    XcdBarrier b; b.bar = bar; b.x = xb_xcc_id(); b.st = st;
    if (threadIdx.x == 0) (void)xb_add(&bar[XB_XCNT(b.x)], 1u);
    return b;
}
__device__ __forceinline__ void xcd_barrier_complete(unsigned* bar, unsigned x, unsigned& nloc, unsigned& nx) {
    const unsigned G = gridDim.x * gridDim.y * gridDim.z;
    unsigned sum, cnt, mine, sp = 0u;
    for (;;) {
        sum = 0u; cnt = 0u; mine = 0u;
#pragma unroll
        for (unsigned j = 0; j < 16; ++j) { const unsigned c = xb_ld(&bar[XB_XCNT(j)]); sum += c; cnt += (c > 0u) ? 1u : 0u; mine = (j == x) ? c : mine; }
        if (sum == G) break;
        __builtin_amdgcn_s_sleep(1);
        if ((++sp & 255u) == 0u) { if (xb_ld(&bar[XB_TMO])) break; if (sp > XB_SPIN_CAP) { atomicAdd(&bar[XB_TMO], 1u); break; } }
    }
    nloc = mine > 0u ? mine : 1u; nx = cnt > 0u ? cnt : 1u;
}

__device__ __forceinline__ void xcd_barrier(const XcdBarrier& b, int tid_in) {
    asm volatile("s_waitcnt vmcnt(0)" ::: "memory");
    __syncthreads();
    if (tid_in == 0) {
        unsigned* bar = b.bar;
        __builtin_amdgcn_s_waitcnt(0);
        unsigned nloc = b.st[0], nx = b.st[1];
        if (nloc == 0u) { xcd_barrier_complete(bar, b.x, nloc, nx); b.st[0] = nloc; b.st[1] = nx; }
        const unsigned old = xb_add(&bar[XB_XSUB(b.x)], 1u);
        const unsigned gen = old / nloc;
        if (old + 1u == (gen + 1u) * nloc) {
            __builtin_amdgcn_fence(__ATOMIC_RELEASE, "agent");
            asm volatile("s_waitcnt vmcnt(0)" ::: "memory");
            const unsigned og = xb_add(&bar[XB_TOP], 1u);
            const unsigned tg = og / nx;
            if (og + 1u == (tg + 1u) * nx) xb_add(&bar[XB_TOPGEN], 1u);
            else XB_SPIN(xb_ld(&bar[XB_TOPGEN]) == tg, bar);
            __builtin_amdgcn_fence(__ATOMIC_ACQUIRE, "agent");
            xb_add(&bar[XB_XGEN(b.x)], 1u);
            asm volatile("s_waitcnt vmcnt(0)" ::: "memory");
        } else {
            XB_SPIN(xb_ld(&bar[XB_XGEN(b.x)]) == gen, bar);
            __builtin_amdgcn_fence(__ATOMIC_ACQUIRE, "agent");
            asm volatile("s_waitcnt vmcnt(0)" ::: "memory");
        }
    }
    __syncthreads();
}

namespace pg8 {
typedef float f32x2_t __attribute__((ext_vector_type(2)));
typedef __bf16 bf16x2_t __attribute__((ext_vector_type(2)));
__device__ __forceinline__ unsigned pk_bf16(float lo, float hi) { const f32x2_t v = {lo, hi}; const bf16x2_t b = __builtin_convertvector(v, bf16x2_t); return __builtin_bit_cast(unsigned, b); }
#define DI_PG8 __device__ __forceinline__
__device__ __forceinline__ float silu_f(float g) { return g * __builtin_amdgcn_rcpf(1.f + __expf(-g)); }
DI_PG8 float row_rstd(const float* part, int row) {
    const f32x4* pp = (const f32x4*)(part + (size_t)row * 8); const f32x4 p0 = pp[0], p1 = pp[1];
    return 1.f / sqrtf((((p0.x + p0.y) + (p0.z + p0.w)) + ((p1.x + p1.y) + (p1.z + p1.w))) * (1.f / 2048.f) + 1e-6f);
}
struct EpiSwiglu {
    static constexpr bool PERM = true, AFTER_DRAIN = false;
    bf16_t* H; int ldh; const PG8_LAS _Float16* rt;
    __device__ __forceinline__ void operator()(const f32x4 (&acc)[2][2][4][2], const Unit& u, int wr, int wc, int fr, int fq) const {
        const int row0 = u.pm * BM + wr * 64 + fr, col0 = u.pn * HALF + wc * 32 + 8 * fq;
#pragma unroll
        for (int ai = 0; ai < 2; ++ai)
#pragma unroll
            for (int m = 0; m < 4; ++m) {
                bf16_t* p = H + (size_t)(row0 + ai * HALF + m * 16) * ldh + col0;
                const float rs = (float)rt[row0 + ai * HALF + m * 16];
                const f32x4 g0 = acc[ai][0][m][0] * rs, g1 = acc[ai][0][m][1] * rs, u0 = acc[ai][1][m][0] * rs, u1 = acc[ai][1][m][1] * rs;
                u32x4 w;
                w.x = pk_bf16(silu_f(g0[0]) * u0[0], silu_f(g0[1]) * u0[1]); w.y = pk_bf16(silu_f(g0[2]) * u0[2], silu_f(g0[3]) * u0[3]);
                w.z = pk_bf16(silu_f(g1[0]) * u1[0], silu_f(g1[1]) * u1[1]); w.w = pk_bf16(silu_f(g1[2]) * u1[2], silu_f(g1[3]) * u1[3]);
                *(u32x4*)p = w;
            }
    }
};
struct EpiResid {
    static constexpr bool PERM = true, AFTER_DRAIN = false;
    bf16_t* X; int ldx; float scale; float* part; PG8_LAS float* lp;
    __device__ __forceinline__ void operator()(const f32x4 (&acc)[2][2][4][2], const Unit& u, int wr, int wc, int fr, int fq) const {
        const int row0 = u.pm * BM + wr * 64 + fr, col0 = u.pn * BM + wc * 32 + 8 * fq;
#pragma unroll
        for (int ai = 0; ai < 2; ++ai)
#pragma unroll
            for (int m = 0; m < 4; ++m) {
                float ss = 0.f;
#pragma unroll
                for (int bj = 0; bj < 2; ++bj) {
                    bf16_t* p = X + (size_t)(row0 + ai * HALF + m * 16) * ldx + col0 + bj * HALF;
                    const u32x4 w = *(const u32x4*)p;
                    const f32x4 a = acc[ai][bj][m][0] * scale, b = acc[ai][bj][m][1] * scale;
                    u32x4 o;
                    o.x = pk_bf16(__uint_as_float(w.x << 16) + a.x, __uint_as_float(w.x & 0xffff0000u) + a.y); o.y = pk_bf16(__uint_as_float(w.y << 16) + a.z, __uint_as_float(w.y & 0xffff0000u) + a.w);
                    o.z = pk_bf16(__uint_as_float(w.z << 16) + b.x, __uint_as_float(w.z & 0xffff0000u) + b.y); o.w = pk_bf16(__uint_as_float(w.w << 16) + b.z, __uint_as_float(w.w & 0xffff0000u) + b.w);
                    *(u32x4*)p = o;
                    const float e0 = __uint_as_float(o.x << 16), e1 = __uint_as_float(o.x & 0xffff0000u), e2 = __uint_as_float(o.y << 16), e3 = __uint_as_float(o.y & 0xffff0000u);
                    const float e4 = __uint_as_float(o.z << 16), e5 = __uint_as_float(o.z & 0xffff0000u), e6 = __uint_as_float(o.w << 16), e7 = __uint_as_float(o.w & 0xffff0000u);
                    ss += ((e0 * e0 + e1 * e1) + (e2 * e2 + e3 * e3)) + ((e4 * e4 + e5 * e5) + (e6 * e6 + e7 * e7));
                }
                { auto r1 = __builtin_amdgcn_permlane16_swap(__float_as_uint(ss), __float_as_uint(ss), false, false); ss = __uint_as_float(r1[0]) + __uint_as_float(r1[1]); }
                { auto r2 = __builtin_amdgcn_permlane32_swap(__float_as_uint(ss), __float_as_uint(ss), false, false); ss = __uint_as_float(r2[0]) + __uint_as_float(r2[1]); }
                if (fq == 0) lp[wc * 256 + ai * HALF + wr * 64 + m * 16 + fr] = ss;
            }
        asm volatile("s_waitcnt lgkmcnt(0)" ::: "memory"); __builtin_amdgcn_s_barrier(); asm volatile("" ::: "memory");
        if (wr == 0) { const int rl = wc * 64 + fq * 16 + fr;
            part[(size_t)(u.pm * BM + rl) * 8 + u.pn] = (lp[rl] + lp[256 + rl]) + (lp[512 + rl] + lp[768 + rl]); }
    }
};
struct EpiF32 {
    static constexpr bool PERM = true, AFTER_DRAIN = false;
    float* C; int ldc;
    __device__ __forceinline__ void operator()(const f32x4 (&acc)[2][2][4][2], const Unit& u, int wr, int wc, int fr, int fq) const {
        const int row0 = u.pm * BM + wr * 64 + fr, col0 = u.pn * BM + wc * 32 + 8 * fq;
#pragma unroll
        for (int ai = 0; ai < 2; ++ai)
#pragma unroll
            for (int m = 0; m < 4; ++m)
#pragma unroll
                for (int bj = 0; bj < 2; ++bj) {
                    float* p = C + (size_t)(row0 + ai * HALF + m * 16) * ldc + col0 + bj * HALF;
                    *(f32x4*)p = acc[ai][bj][m][0]; *(f32x4*)(p + 4) = acc[ai][bj][m][1];
                }
    }
};
struct EpiBf16 {
    static constexpr bool PERM = true, AFTER_DRAIN = false;
    bf16_t* C; int ldc; const PG8_LAS _Float16* rt;
    __device__ __forceinline__ void operator()(const f32x4 (&acc)[2][2][4][2], const Unit& u, int wr, int wc, int fr, int fq) const {
        const int row0 = u.pm * BM + wr * 64 + fr, col0 = u.pn * BM + wc * 32 + 8 * fq;
#pragma unroll
        for (int ai = 0; ai < 2; ++ai)
#pragma unroll
            for (int m = 0; m < 4; ++m) {
                const float rs = rt ? (float)rt[row0 + ai * HALF + m * 16] : 1.f;
#pragma unroll
                for (int bj = 0; bj < 2; ++bj) {
                    const f32x4 v0 = acc[ai][bj][m][0] * rs, v1 = acc[ai][bj][m][1] * rs;
                    u32x4 w; w.x = pk_bf16(v0[0], v0[1]); w.y = pk_bf16(v0[2], v0[3]); w.z = pk_bf16(v1[0], v1[1]); w.w = pk_bf16(v1[2], v1[3]);
                    *(u32x4*)(C + (size_t)(row0 + ai * HALF + m * 16) * ldc + col0 + bj * HALF) = w;
                } }
    }
};
struct EpiVT {
    static constexpr bool PERM = true, AFTER_DRAIN = false;
    bf16_t* C; int ldc;
    __device__ __forceinline__ void operator()(const f32x4 (&acc)[2][2][4][2], const Unit& u, int wr, int wc, int fr, int fq) const {
        const int row0 = u.pm * BM + wr * 64 + fr, col0 = u.pn * BM + wc * 32 + 8 * fq, g = fq & 1;
#pragma unroll
        for (int ai = 0; ai < 2; ++ai)
#pragma unroll
            for (int m = 0; m < 4; ++m)
#pragma unroll
                for (int bj = 0; bj < 2; ++bj) {
                    bf16_t* p = C + (size_t)(row0 + ai * HALF + m * 16) * ldc + ((col0 + bj * HALF) & ~15);
                    const f32x4 v0 = acc[ai][bj][m][0], v1 = acc[ai][bj][m][1];
                    typedef unsigned u32x2_ __attribute__((ext_vector_type(2)));
                    u32x2_ w0, w1; w0.x = pk_bf16(v0[0], v0[1]); w0.y = pk_bf16(v0[2], v0[3]); w1.x = pk_bf16(v1[0], v1[1]); w1.y = pk_bf16(v1[2], v1[3]);
                    *(u32x2_*)(p + 4 * g) = w0; *(u32x2_*)(p + 8 + 4 * g) = w1;
                }
    }
};
}

#ifndef MK_SINGLE
#define MK_SINGLE 0
#endif
constexpr int NWAVES = 8;
constexpr int S = 8192, D = 2048, FF = 5632, NL = 4;
constexpr int IN_COLS = 5696, ZC = 5888;
constexpr int ZC_SBQ = 0, ZC_SBK = 512, ZC_SBV = 1024, ZC_CQ = 1536, ZC_CKV = 2048, ZC_KR = 2304, ZC_RW = 2560;
constexpr float EPS = 1e-6f;
enum { I_X = 0, I_POS, I_F1N, I_F1G, I_F1U, I_F1D, I_MIXN, I_WIN, I_QN, I_WUQ, I_KVN, I_WUKV, I_MU, I_W0, I_W2, I_A0, I_A2, I_G2, I_KK, I_KA, I_RK, I_LNW, I_LNB,
       I_SBN, I_MLAN, I_WOUT, I_F2N, I_F2G, I_F2U, I_F2D, I_FN, N_IN };

constexpr size_t MiB = 1u << 20;
constexpr size_t WS_CTL = 0, CTL_ZERO_BYTES = 1 * MiB;
constexpr size_t WS_COS = 1 * MiB, WS_SIN = 2 * MiB;
constexpr size_t WS_W = 4 * MiB;
constexpr size_t W_GU0 = WS_W, W_DN0 = WS_W + 44 * MiB, W_GU1 = WS_W + 66 * MiB, W_DN1 = WS_W + 110 * MiB, W_IN = WS_W + 132 * MiB, W_OUT = WS_W + 155 * MiB,
                 W_UQ = WS_W + 163 * MiB, W_UKVV = WS_W + 163 * MiB + 768 * 1024, W_UKV = WS_W + 164 * MiB, W_LORA = WS_W + 165 * MiB;
constexpr size_t WS_HN = 172 * MiB, WS_CAT = 204 * MiB, WS_M = 236 * MiB;
constexpr size_t WS_Z = WS_M, WS_H = WS_M;
constexpr size_t WS_QS = WS_M + 184 * MiB, WS_KS = WS_M + 192 * MiB, WS_VS = WS_M + 200 * MiB, WS_CQN = WS_M + 208 * MiB, WS_CKVN = WS_M + 216 * MiB, WS_LORAA = WS_M + 220 * MiB;
constexpr size_t WS_PO = WS_M + 536 * MiB;
constexpr size_t WS_PML = WS_M + 648 * MiB;
constexpr int CW_QUEUE = 16384;
constexpr size_t WS_CHK = WS_M + 696 * MiB;
constexpr size_t WS_QMF = WS_M + 224 * MiB, WS_KVMF = WS_M + 248 * MiB, WS_LOF = WS_M + 280 * MiB;
constexpr size_t WS_QM = WS_M + 376 * MiB, WS_KM = WS_M + 388 * MiB, WS_VM = WS_M + 400 * MiB, WS_VT = WS_VM;
constexpr size_t WS_RR = WS_M + 408 * MiB, WS_RW = WS_M + 440 * MiB, WS_RK = WS_M + 472 * MiB, WS_RV = WS_M + 504 * MiB, WS_RKK = WS_M + 536 * MiB, WS_RB = WS_M + 568 * MiB, WS_RG = WS_M + 600 * MiB;
constexpr size_t WS_YSB = WS_M + 632 * MiB, WS_YMLA = WS_M + 648 * MiB, WS_YRW = WS_M + 664 * MiB;
constexpr size_t WS_END0 = WS_M + 696 * MiB;
constexpr size_t WB_DELTA = WS_END0 + 152 * MiB - WS_W;
constexpr size_t WS_XB = WS_END0 + 152 * MiB + 168 * MiB;
constexpr size_t WS_PART = WS_XB + 32 * MiB;
constexpr size_t WS_END = WS_PART + 1 * MiB;
constexpr int CW_CQ = 20480, CW_DONE = 24576;
constexpr int CW_BAR = 4096;

constexpr int RING_BYTES = 131072, LDS_BYTES = 163840, MISC_OFF = LDS_BYTES - 512;

namespace pg8 {
struct EpiQM {
    static constexpr bool PERM = true, AFTER_DRAIN = false;
    unsigned char* ws;
    __device__ __forceinline__ void operator()(const f32x4 (&acc)[2][2][4][2], const Unit& u, int wr, int wc, int fr, int fq) const {
        const int row0 = u.pm * BM + wr * 64 + fr, col0 = u.pn * BM + wc * 32 + 8 * fq;
        bf16_t* C = (bf16_t*)(ws + WS_QM); const float* ct = (const float*)(ws + WS_COS); const float* st = (const float*)(ws + WS_SIN);
        const float scale = 0.07216878364870322f * 1.4426950408889634f;
#pragma unroll
        for (int bj = 0; bj < 2; ++bj) {
            const int col = col0 + bj * HALF, d = col % 192;
#pragma unroll
            for (int ai = 0; ai < 2; ++ai)
#pragma unroll
                for (int m = 0; m < 4; ++m) {
                    const int row = row0 + ai * HALF + m * 16;
                    f32x4 v0 = acc[ai][bj][m][0] * scale, v1 = acc[ai][bj][m][1] * scale;
                    if (d >= 128) {
                        const int i0 = (d - 128) >> 1;
                        const f32x4 cs = *(const f32x4*)(ct + (size_t)row * 32 + i0), sn = *(const f32x4*)(st + (size_t)row * 32 + i0);
                        const f32x4 a0 = v0, a1 = v1;
                        v0.x = a0.x * cs.x - a0.y * sn.x; v0.y = a0.x * sn.x + a0.y * cs.x; v0.z = a0.z * cs.y - a0.w * sn.y; v0.w = a0.z * sn.y + a0.w * cs.y;
                        v1.x = a1.x * cs.z - a1.y * sn.z; v1.y = a1.x * sn.z + a1.y * cs.z; v1.z = a1.z * cs.w - a1.w * sn.w; v1.w = a1.z * sn.w + a1.w * cs.w;
                    }
                    u32x4 w; w.x = pk_bf16(v0[0], v0[1]); w.y = pk_bf16(v0[2], v0[3]); w.z = pk_bf16(v1[0], v1[1]); w.w = pk_bf16(v1[2], v1[3]);
                    *(u32x4*)(C + (size_t)row * 768 + col) = w;
                }
        }
    }
};
struct EpiKM {
    static constexpr bool PERM = true, AFTER_DRAIN = false;
    unsigned char* ws;
    __device__ __forceinline__ void operator()(const f32x4 (&acc)[2][2][4][2], const Unit& u, int wr, int wc, int fr, int fq) const {
        const int row0 = u.pm * BM + wr * 64 + fr, col0 = u.pn * BM + wc * 32 + 8 * fq;
        bf16_t* C = (bf16_t*)(ws + WS_KM);
#pragma unroll
        for (int ai = 0; ai < 2; ++ai)
#pragma unroll
            for (int m = 0; m < 4; ++m)
#pragma unroll
                for (int bj = 0; bj < 2; ++bj) {
                    const int col = col0 + bj * HALF;
                    const f32x4 v0 = acc[ai][bj][m][0], v1 = acc[ai][bj][m][1];
                    u32x4 w; w.x = pk_bf16(v0[0], v0[1]); w.y = pk_bf16(v0[2], v0[3]); w.z = pk_bf16(v1[0], v1[1]); w.w = pk_bf16(v1[2], v1[3]);
                    *(u32x4*)(C + (size_t)(row0 + ai * HALF + m * 16) * 768 + 192 * (col >> 7) + (col & 127)) = w;
                }
    }
};
}

#define DI __device__ __forceinline__
typedef unsigned short bf16;
typedef unsigned v4u __attribute__((ext_vector_type(4)));
typedef unsigned v2u __attribute__((ext_vector_type(2)));
typedef float f32x4 __attribute__((ext_vector_type(4)));
typedef float f32x2 __attribute__((ext_vector_type(2)));
#define LDS_WAIT() asm volatile("s_waitcnt lgkmcnt(0)" ::: "memory")
DI float bf2f(unsigned b) { return __uint_as_float(b << 16); }
DI float bflo(unsigned w) { return __uint_as_float(w << 16); }
DI float bfhi(unsigned w) { return __uint_as_float(w & 0xffff0000u); }
DI unsigned pk2(float lo, float hi) { return pg8::pk_bf16(lo, hi); }
DI float sq8(const v4u& w) { return (bflo(w.x) * bflo(w.x) + bfhi(w.x) * bfhi(w.x)) + (bflo(w.y) * bflo(w.y) + bfhi(w.y) * bfhi(w.y)) + (bflo(w.z) * bflo(w.z) + bfhi(w.z) * bfhi(w.z)) + (bflo(w.w) * bflo(w.w) + bfhi(w.w) * bfhi(w.w)); }
template <int CTRL> DI float dpp_add(float v) { return v + __builtin_bit_cast(float, __builtin_amdgcn_update_dpp(0, __builtin_bit_cast(int, v), CTRL, 0xf, 0xf, true)); }
DI float row16_sum(float v) { v = dpp_add<0xB1>(v); v = dpp_add<0x4E>(v); v = dpp_add<0x141>(v); v = dpp_add<0x140>(v); return v; }
DI float wave_sum(float v) {
    v = row16_sum(v);
    return (__builtin_bit_cast(float, __builtin_amdgcn_readlane(__builtin_bit_cast(int, v), 0)) + __builtin_bit_cast(float, __builtin_amdgcn_readlane(__builtin_bit_cast(int, v), 16)))
         + (__builtin_bit_cast(float, __builtin_amdgcn_readlane(__builtin_bit_cast(int, v), 32)) + __builtin_bit_cast(float, __builtin_amdgcn_readlane(__builtin_bit_cast(int, v), 48)));
}
template <int W> DI float grp_sum(float v) {
    v = dpp_add<0xB1>(v); v = dpp_add<0x4E>(v);
    if (W >= 8) v = dpp_add<0x141>(v);
    if (W >= 16) v = dpp_add<0x140>(v);
    return v;
}
DI float sigmoid_f(float x) { return __builtin_amdgcn_rcpf(1.f + __expf(-x)); }
DI float softplus_f(float x) { return fmaxf(x, 0.f) + __logf(1.f + __expf(-fabsf(x))); }
DI float tanh_f(float x) { const float xc = fminf(fmaxf(x, -15.f), 15.f); const float t = __expf(2.f * xc); return (t - 1.f) * __builtin_amdgcn_rcpf(t + 1.f); }

DI int fresh_tid(int wave) { int l_; asm volatile("v_mbcnt_lo_u32_b32 %0, -1, 0\n\tv_mbcnt_hi_u32_b32 %0, -1, %0" : "=v"(l_)); return (wave << 6) | l_; }
DI f32x4 ldz4(const bf16* p) { const v2u w = *(const v2u*)p; return (f32x4){bflo(w.x), bfhi(w.x), bflo(w.y), bfhi(w.y)}; }
DI f32x2 ldz2(const bf16* p) { const unsigned w = *(const unsigned*)p; return (f32x2){bflo(w), bfhi(w)}; }
struct Args { const float* in[N_IN]; float* out; unsigned char* ws; int ph_lo, ph_hi; };
typedef const __attribute__((address_space(4))) unsigned char* kaptr_t;
struct KA { kaptr_t p;
    DI const float* in(int i) const { return *(const float* const __attribute__((address_space(4)))*)(p + 8 * i); }
    DI float* out() const { return *(float* const __attribute__((address_space(4)))*)(p + 8 * N_IN); }
    DI unsigned char* ws() const { return *(unsigned char* const __attribute__((address_space(4)))*)(p + 8 * N_IN + 8); } };

struct TI { const float* W; bf16* WT; int N, k0, n0, ldk, drow0, kcol0; const float* gk; int rs; };
DI void ti_load(const TI& t, float (&wv)[32], int lane) {
#pragma unroll
    for (int i = 0; i < 32; ++i) { const int kk = 2 * i + (lane >> 5); wv[i] = __builtin_nontemporal_load(t.W + (size_t)(t.k0 + kk) * t.N + t.n0 + (lane & 31)); }
}
DI void ti_store(const TI& t, const float (&wv)[32], LAS float* scr, int lane) {
#pragma unroll
    for (int i = 0; i < 32; ++i) { const int kk = 2 * i + (lane >> 5); scr[kk * 33 + (lane & 31)] = wv[i]; }
    LDS_WAIT(); asm volatile("" ::: "memory");
    const int c = lane & 7;
    f32x4 g0 = {1.f, 1.f, 1.f, 1.f}, g1 = g0;
    if (t.gk) { g0 = *(const f32x4*)(t.gk + 8 * c); g1 = *(const f32x4*)(t.gk + 8 * c + 4); }
#pragma unroll
    for (int j = 0; j < 4; ++j) { const int n = (lane >> 3) + 8 * j; const LAS float* s = scr + (8 * c) * 33 + n;
        v4u o; o.x = pk2(s[0 * 33] * g0.x, s[1 * 33] * g0.y); o.y = pk2(s[2 * 33] * g0.z, s[3 * 33] * g0.w); o.z = pk2(s[4 * 33] * g1.x, s[5 * 33] * g1.y); o.w = pk2(s[6 * 33] * g1.z, s[7 * 33] * g1.w);
        __builtin_nontemporal_store(o, (v4u*)(t.WT + (size_t)(t.drow0 + n * t.rs) * t.ldk + t.kcol0 + t.k0 + 8 * c)); }
    LDS_WAIT(); asm volatile("" ::: "memory");
}

namespace cv {
constexpr int I_FF = (D / 64) * (FF / 32);
constexpr int I_IN = (D / 64) * (IN_COLS / 32);
constexpr int I_OUT = (D / 64) * (D / 32);
constexpr int I_UQ = (512 / 64) * (768 / 32), I_UKV = 64, N_W2 = 32, N_A2 = 32, N_G2 = 64;
constexpr int I_UKVV = 64;
constexpr int TOTAL = 6 * I_FF + I_IN + I_OUT + I_UQ + I_UKV + I_UKVV + N_W2 + N_A2 + N_G2;
}
DI TI conv_params(const KA& a, int l, unsigned char* ws, int it) {
    using namespace cv;
        int r = it;
        if (r < 6 * I_FF) {
            const int m = r / I_FF; r -= m * I_FF; const int f = m / 3, t = m % 3;
            if (t < 2) {
                const float* src = (f ? (t ? a.in(I_F2U) : a.in(I_F2G)) : (t ? a.in(I_F1U) : a.in(I_F1G))) + (size_t)l * D * FF;
                const int nblk = FF / 32, kb = r / nblk, nb = r % nblk, n0 = 32 * nb;
                return TI{src, (bf16*)(ws + (f ? W_GU1 : W_GU0)), FF, 64 * kb, n0, D, 256 * (n0 >> 7) + (n0 & 127) + 128 * t, 0, (f ? a.in(I_F2N) : a.in(I_F1N)) + l * D + 64 * kb, 1};
            } else {
                const float* src = (f ? a.in(I_F2D) : a.in(I_F1D)) + (size_t)l * FF * D;
                const int nblk = D / 32, kb = r / nblk, nb = r % nblk, n0 = 32 * nb;
                return TI{src, (bf16*)(ws + (f ? W_DN1 : W_DN0)), D, 64 * kb, n0, FF, n0, 0, nullptr, 1};
            }

        }
        r -= 6 * I_FF;
        if (r < I_IN) { const int nblk = IN_COLS / 32, kb = r / nblk, nb = r % nblk, n0 = 32 * nb;
            return TI{a.in(I_WIN) + (size_t)l * D * IN_COLS, (bf16*)(ws + W_IN), IN_COLS, 64 * kb, n0, D, n0 < 2368 ? n0 : n0 + 192, 0, a.in(I_MIXN) + l * D + 64 * kb, 1}; }
        r -= I_IN;
        if (r < I_OUT) { const int nblk = D / 32, kb = r / nblk, nb = r % nblk, n0 = 32 * nb;
            return TI{a.in(I_WOUT) + (size_t)l * D * D, (bf16*)(ws + W_OUT), D, 64 * kb, n0, D, n0, 0, nullptr, 1}; }
        r -= I_OUT;
        if (r < I_UQ) { const int nblk = 768 / 32, kb = r / nblk, nb = r % nblk, n0 = 32 * nb, hb = nb / 6, b = nb % 6;
            return TI{a.in(I_WUQ) + (size_t)l * 512 * 768, (bf16*)(ws + W_UQ), 768, 64 * kb, n0, 512, b < 4 ? n0 : 192 * hb + 128 + (b - 4), 0, nullptr, b < 4 ? 1 : 2}; }
        r -= I_UQ;
        if (r < I_UKV) { const int kb = r >> 4, vb = r & 15, n0 = 256 * (vb >> 2) + 32 * (vb & 3);
            return TI{a.in(I_WUKV) + (size_t)l * 256 * 1024, (bf16*)(ws + W_UKV), 1024, 64 * kb, n0, 256, 128 * (vb >> 2) + 32 * (vb & 3), 0, nullptr, 1}; }
        r -= I_UKV;
        if (r < I_UKVV) { const int kb = r >> 4, vb = r & 15, n0 = 256 * (vb >> 2) + 128 + 32 * (vb & 3);
            return TI{a.in(I_WUKV) + (size_t)l * 256 * 1024, (bf16*)(ws + W_UKVV), 1024, 64 * kb, n0, 256, 128 * (vb >> 2) + 32 * (vb & 3), 0, nullptr, 1}; }
        r -= I_UKVV;
        if (r < N_W2) { const int n0 = 32 * r;
            return TI{a.in(I_W2) + (size_t)l * 64 * 1024, (bf16*)(ws + W_LORA), 1024, 0, n0, 256, 2 * n0, 0, nullptr, 2}; }
        r -= N_W2;
        if (r < N_A2) { const int n0 = 32 * r;
            return TI{a.in(I_A2) + (size_t)l * 64 * 1024, (bf16*)(ws + W_LORA), 1024, 0, n0, 256, 2 * n0 + 1, 64, nullptr, 2}; }
        r -= N_A2;
        { const int kb = r / 32, nb = r % 32, n0 = 32 * nb;
            return TI{a.in(I_G2) + (size_t)l * 128 * 1024, (bf16*)(ws + W_LORA), 1024, 64 * kb, n0, 256, 2048 + n0, 128, nullptr, 1}; }
}
DI void conv_phase(const KA& a, int l, LAS unsigned char* lds, int gw, int ngw, int wave, int lane) {
    LAS float* scr = (LAS float*)(lds + wave * 16384);
    unsigned char* ws = a.ws();
    for (int it = gw; it < cv::TOTAL; it += 2 * ngw) {
        const TI ta = conv_params(a, l, ws, it); const bool hb = it + ngw < cv::TOTAL; const TI tb = conv_params(a, l, ws, hb ? it + ngw : it);
        float wa[32], wb[32];
        ti_load(ta, wa, lane); if (hb) ti_load(tb, wb, lane);
        ti_store(ta, wa, scr, lane); if (hb) ti_store(tb, wb, scr, lane);
    }
    unsigned zz = 0u; asm volatile("" : "+v"(zz)); const v4u zv = {zz, zz, zz, zz};
    for (int i = gw * 64 + lane; i < 3072 * 32; i += ngw * 64) {
        const int row = i >> 5, ch = i & 31, blk = row >> 10;
        const bool data = blk < 2 ? ((row & 1) ? (ch >= 8 && ch < 16) : (ch < 8)) : (ch >= 16);
        if (!data) *(v4u*)((bf16*)(ws + W_LORA) + (size_t)row * 256 + 8 * ch) = zv;
    }
    for (int i = gw * 64 + lane; i < 192 * (D / 8); i += ngw * 64) *(v4u*)((bf16*)(ws + W_IN) + (size_t)2368 * D + (size_t)i * 8) = zv;
    if (l == 0) {
        for (int t = gw; t < S; t += ngw) {
            const f32x4* xr = (const f32x4*)(a.in(I_X) + (size_t)t * D) + 2 * lane; v4u* xo = (v4u*)((bf16*)(ws + WS_XB) + (size_t)t * D) + lane; float ss = 0.f;
#pragma unroll
            for (int j = 0; j < 4; ++j) { const f32x4 v0 = __builtin_nontemporal_load(xr + 128 * j), v1 = __builtin_nontemporal_load(xr + 128 * j + 1); v4u w; w.x = pk2(v0.x, v0.y); w.y = pk2(v0.z, v0.w); w.z = pk2(v1.x, v1.y); w.w = pk2(v1.z, v1.w); xo[64 * j] = w; ss += sq8(w); }
            ss = wave_sum(ss);
            if (lane == 0) { float z0 = 0.f; asm volatile("" : "+v"(z0)); f32x4* pp = (f32x4*)((float*)(ws + WS_PART) + (size_t)t * 8); pp[0] = (f32x4){ss, z0, z0, z0}; pp[1] = (f32x4){z0, z0, z0, z0}; }
        }
        const int* pos = (const int*)a.in(I_POS); float* ct = (float*)(ws + WS_COS); float* st = (float*)(ws + WS_SIN);
        for (int i = gw * 64 + lane; i < S * 32; i += ngw * 64) {
            const int t = i >> 5, j = i & 31;
            const float inv_freq = expf(-(float)j * (1.f / 32.f) * 9.210340371976184f);
            const float ang = (float)pos[t] * inv_freq;
            const double rev = (double)ang * 0.15915494309189535; const float fr = (float)(rev - __builtin_rint(rev));
            ct[i] = __builtin_amdgcn_cosf(fr); st[i] = __builtin_amdgcn_sinf(fr);
        }
    }
}

constexpr int CQ_BLK = (cv::TOTAL + 7) / 8, CQ_ZCH = 3072 * 32 + 192 * (D / 8), CQ_ZERO = (CQ_ZCH + 4095) / 4096, CQ_ITEMS = CQ_BLK + CQ_ZERO;
DI void conv_queue_item(const KA& a, int L, unsigned char* wsw, int ci, int tid_in, LAS unsigned char* lds) {
    int tc = tid_in; asm volatile("" : "+v"(tc));
    const int wave = tc >> 6, lane = tc & 63;
    if (ci < CQ_BLK) {
        const int it = ci * 8 + wave;
        if (it < cv::TOTAL) { const TI t = conv_params(a, L, wsw, it); float wv[32]; ti_load(t, wv, lane); ti_store(t, wv, (LAS float*)(lds + wave * 16384), lane); }
    } else {
        unsigned zz = 0u; asm volatile("" : "+v"(zz)); const v4u zv = {zz, zz, zz, zz};
#pragma unroll
        for (int k = 0; k < 8; ++k) {
            const int i = (ci - CQ_BLK) * 4096 + k * 512 + tc;
            if (i < 3072 * 32) { const int row = i >> 5, ch = i & 31, blk = row >> 10;
                const bool data = blk < 2 ? ((row & 1) ? (ch >= 8 && ch < 16) : (ch < 8)) : (ch >= 16);
                if (!data) *(v4u*)((bf16*)(wsw + W_LORA) + (size_t)row * 256 + 8 * ch) = zv; }
            else if (i < CQ_ZCH) *(v4u*)((bf16*)(wsw + W_IN) + (size_t)2368 * D + (size_t)(i - 3072 * 32) * 8) = zv;
        }
    }
}
DI void conv_harvest(const KA& a, int L, int ph, int G, int tid, LAS unsigned char* lds) {
    unsigned char* ws = a.ws(); unsigned char* wsw = ws + ((L & 1) ? WB_DELTA : 0);
    unsigned* cq = (unsigned*)(ws + WS_CTL) + CW_CQ + 64 * L; unsigned* done = (unsigned*)(ws + WS_CTL) + CW_DONE + 64 * (ph < 0 ? 0 : ph);
    volatile LAS unsigned* slot = (volatile LAS unsigned*)(lds + MISC_OFF + 64);
    __syncthreads();
    if (ph >= 0 && tid == 0) (void)__hip_atomic_fetch_add(done, 1u, __ATOMIC_RELAXED, __HIP_MEMORY_SCOPE_AGENT);
    for (;;) {
        if (tid == 0) {
            unsigned it = 0x7fffffffu;
            if (ph < 0 || __hip_atomic_load(done, __ATOMIC_RELAXED, __HIP_MEMORY_SCOPE_AGENT) < (unsigned)G) it = __hip_atomic_fetch_add(cq, 1u, __ATOMIC_RELAXED, __HIP_MEMORY_SCOPE_AGENT);
            *slot = it;
        }
        __syncthreads();
        const int ci = (int)*slot;
        __syncthreads();
        if (ci >= CQ_ITEMS) break;
        conv_queue_item(a, L, wsw, ci, tid, lds);
    }
}
DI void rstd_table(const pg8::StaticOrder& So, const float* part, LAS _Float16* rt, int tid) {
    if (tid < 256) {
        pg8::Unit u;
#pragma unroll
        for (int i = 0; i < 6; ++i) if (So.next(i, u)) rt[u.pm * 256 + tid] = (_Float16)pg8::row_rstd(part, u.pm * 256 + tid);
#pragma unroll 1
        for (int i = 6; So.next(i, u); ++i) rt[u.pm * 256 + tid] = (_Float16)pg8::row_rstd(part, u.pm * 256 + tid);
    }
    __syncthreads();
}
DI void rms_row_bf16(const bf16* xrow, const float* g, bf16* orow, int lane) {
    const v4u* xr = (const v4u*)xrow + lane; const f32x4* gr = (const f32x4*)g + 2 * lane;
    v4u v[4]; float s = 0.f;
#pragma unroll
    for (int j = 0; j < 4; ++j) { v[j] = xr[64 * j]; s += sq8(v[j]); }
    const float rstd = 1.f / sqrtf(wave_sum(s) * (1.f / D) + EPS);
    v4u* o = (v4u*)orow + lane;
#pragma unroll
    for (int j = 0; j < 4; ++j) { const f32x4 g0 = gr[128 * j], g1 = gr[128 * j + 1]; v4u w;
        w.x = pk2(bflo(v[j].x) * rstd * g0.x, bfhi(v[j].x) * rstd * g0.y); w.y = pk2(bflo(v[j].y) * rstd * g0.z, bfhi(v[j].y) * rstd * g0.w);
        w.z = pk2(bflo(v[j].z) * rstd * g1.x, bfhi(v[j].z) * rstd * g1.y); w.w = pk2(bflo(v[j].w) * rstd * g1.z, bfhi(v[j].w) * rstd * g1.w); o[64 * j] = w; }
}
DI void norm_phase(const bf16* x, const float* g, bf16* hn, int gw, int ngw, int lane) {
    for (int t = gw; t < S; t += ngw) rms_row_bf16(x + (size_t)t * D, g, hn + (size_t)t * D, lane);
}
DI void final_phase(const bf16* x, float* out, const float* g, int gw, int ngw, int lane) {
    for (int t = gw; t < S; t += ngw) {
        const v4u* xr = (const v4u*)(x + (size_t)t * D) + lane; const f32x4* gr = (const f32x4*)g + 2 * lane; f32x4* orow = (f32x4*)(out + (size_t)t * D) + 2 * lane;
        v4u v[4]; float s = 0.f;
#pragma unroll
        for (int j = 0; j < 4; ++j) { v[j] = xr[64 * j]; s += sq8(v[j]); }
        const float rstd = 1.f / sqrtf(wave_sum(s) * (1.f / D) + EPS);
#pragma unroll
        for (int j = 0; j < 4; ++j) { const f32x4 g0 = gr[128 * j], g1 = gr[128 * j + 1];
            __builtin_nontemporal_store((f32x4){bflo(v[j].x), bfhi(v[j].x), bflo(v[j].y), bfhi(v[j].y)} * rstd * g0, orow + 128 * j); __builtin_nontemporal_store((f32x4){bflo(v[j].z), bfhi(v[j].z), bflo(v[j].w), bfhi(v[j].w)} * rstd * g1, orow + 128 * j + 1); }
    }
}

DI void prep1_phase(const KA& a, int l, int gw, int ngw, int lane) {
    unsigned char* ws = a.ws();
    const bf16* Z = (const bf16*)(ws + WS_Z);
    bf16* QS = (bf16*)(ws + WS_QS); bf16* KS = (bf16*)(ws + WS_KS); bf16* VS = (bf16*)(ws + WS_VS);
    bf16* CQN = (bf16*)(ws + WS_CQN); bf16* CKVN = (bf16*)(ws + WS_CKVN); bf16* LA = (bf16*)(ws + WS_LORAA);
    unsigned* RKP = (unsigned*)(ws + WS_RR); bf16* VB = (bf16*)(ws + WS_RV);
    const float* qn = a.in(I_QN) + l * 512; const float* kvn = a.in(I_KVN) + l * 256; const float* mu = a.in(I_MU) + l * 3328;
    const float sbscale = 0.08838834764831845f;
    for (int t = gw; t < S; t += ngw) {
        const bf16* z = Z + (size_t)t * ZC;
        {
            const f32x4 c0 = ldz4(z + ZC_CQ + 8 * lane), c1 = ldz4(z + ZC_CQ + 8 * lane + 4);
            float s = (c0.x * c0.x + c0.y * c0.y) + (c0.z * c0.z + c0.w * c0.w) + (c1.x * c1.x + c1.y * c1.y) + (c1.z * c1.z + c1.w * c1.w);
            const float rstd = 1.f / sqrtf(wave_sum(s) * (1.f / 512.f) + EPS);
            const f32x4 g0 = *(const f32x4*)(qn + 8 * lane), g1 = *(const f32x4*)(qn + 8 * lane + 4);
            v4u w; w.x = pk2(c0.x * rstd * g0.x, c0.y * rstd * g0.y); w.y = pk2(c0.z * rstd * g0.z, c0.w * rstd * g0.w);
            w.z = pk2(c1.x * rstd * g1.x, c1.y * rstd * g1.y); w.w = pk2(c1.z * rstd * g1.z, c1.w * rstd * g1.w);
            *(v4u*)(CQN + (size_t)t * 512 + 8 * lane) = w;
        }
        {
            const f32x4 c0 = ldz4(z + ZC_CKV + 4 * lane);
            float s = (c0.x * c0.x + c0.y * c0.y) + (c0.z * c0.z + c0.w * c0.w);
            const float rstd = 1.f / sqrtf(wave_sum(s) * (1.f / 256.f) + EPS);
            const f32x4 g0 = *(const f32x4*)(kvn + 4 * lane);
            v2u w; w.x = pk2(c0.x * rstd * g0.x, c0.y * rstd * g0.y); w.y = pk2(c0.z * rstd * g0.z, c0.w * rstd * g0.w);
            *(v2u*)(CKVN + (size_t)t * 256 + 4 * lane) = w;
        }
        {
            const bf16* zr = z + ZC_RW; const bf16* zp = zr - ZC; const bool has_prev = t > 0;
#pragma unroll
            for (int j = 0; j < 4; ++j) {
                f32x4 x3[3];
#pragma unroll
                for (int part = 0; part < 3; ++part) { const int c = part * 1024 + 4 * lane + 256 * j;
                    const f32x4 zc = ldz4(zr + c); f32x4 zq = {0.f, 0.f, 0.f, 0.f}; if (has_prev) zq = ldz4(zp + c);
                    const f32x4 m = *(const f32x4*)(mu + c); x3[part] = zc + (zq - zc) * m; }
                v4u wrk; wrk.x = pk2(x3[0].x, x3[1].x); wrk.y = pk2(x3[0].y, x3[1].y); wrk.z = pk2(x3[0].z, x3[1].z); wrk.w = pk2(x3[0].w, x3[1].w);
                *(v4u*)(RKP + (size_t)t * 1024 + 4 * lane + 256 * j) = wrk;
                v2u wv; wv.x = pk2(x3[2].x, x3[2].y); wv.y = pk2(x3[2].z, x3[2].w);
                *(v2u*)(VB + (size_t)t * 1024 + 4 * lane + 256 * j) = wv;
            }
            { const int c = 3072 + lane; const float zc = bf2f(zr[c]), zq = has_prev ? bf2f(zp[c]) : 0.f; const float xw = zc + (zq - zc) * mu[c];
              const int c2 = 3136 + lane; const float zc2 = bf2f(zr[c2]), zq2 = has_prev ? bf2f(zp[c2]) : 0.f; const float xa = zc2 + (zq2 - zc2) * mu[c2];
              const int c3 = 3200 + 2 * lane; const f32x2 zc3 = ldz2(zr + c3); f32x2 zq3 = {0.f, 0.f}; if (has_prev) zq3 = ldz2(zp + c3);
              const f32x2 m3 = *(const f32x2*)(mu + c3); const f32x2 xg = zc3 + (zq3 - zc3) * m3;
              bf16* la = LA + (size_t)t * 256;
              la[lane] = (bf16)(pk2(tanh_f(xw), 0.f) & 0xffffu); la[64 + lane] = (bf16)(pk2(xa, 0.f) & 0xffffu);
              *(unsigned*)(la + 128 + 2 * lane) = pk2(sigmoid_f(xg.x), sigmoid_f(xg.y)); }
        }
    }
}

DI void prep2_phase(const KA& a, int l, int gw, int ngw, int lane) {
    unsigned char* ws = a.ws();
    const bf16* Z = (const bf16*)(ws + WS_Z); const float* CT = (const float*)(ws + WS_COS); const float* ST = (const float*)(ws + WS_SIN); bf16* KM = (bf16*)(ws + WS_KM);
    for (int t = gw; t < S; t += ngw) {
        const bf16* kr = Z + (size_t)t * ZC + ZC_KR; bf16* km = KM + (size_t)t * 768;
        const int i32 = lane & 31, hb = 2 * (lane >> 5); const float cs = CT[t * 32 + i32], sn = ST[t * 32 + i32];
        const float kr1 = bf2f(kr[i32]), kr2 = bf2f(kr[32 + i32]);
        const unsigned w = pk2(kr1 * cs - kr2 * sn, kr1 * sn + kr2 * cs);
        *(unsigned*)(km + 192 * hb + 128 + 2 * i32) = w; *(unsigned*)(km + 192 * (hb + 1) + 128 + 2 * i32) = w;
    }
}

DI float dot2bf(unsigned a, unsigned b, float c) { return __builtin_amdgcn_fdot2_f32_bf16(__builtin_bit_cast(pg8::bf16x2_t, a), __builtin_bit_cast(pg8::bf16x2_t, b), c, false); }
constexpr int SB_PF = 6, SB_NR = 7, SB_RING = SB_NR * 2048;
template <int SB_PF, int SB_NR> DI void sb_item(const bf16* __restrict__ QS, const bf16* __restrict__ KS, const bf16* __restrict__ VS, bf16* __restrict__ Y, int h, int grp, int lane, LAS unsigned char* ring) {
    const int ql = lane >> 2, c = lane & 3, t = 16 * grp + ql, co = 128 * h + 32 * c;
    unsigned q[16]; float o[32];
    { const v4u* qp = (const v4u*)(QS + (size_t)t * ZC + co);
#pragma unroll
      for (int j = 0; j < 4; ++j) { const v4u w = qp[j]; q[4 * j] = w.x; q[4 * j + 1] = w.y; q[4 * j + 2] = w.z; q[4 * j + 3] = w.w; } }
    asm volatile("s_waitcnt vmcnt(0)" ::: "memory");
#pragma unroll
    for (int j = 0; j < 16; ++j) asm volatile("" : "+v"(q[j]));
#pragma unroll
    for (int i = 0; i < 32; ++i) o[i] = 0.f;
    float R = 0.f;
    const int s_top = 16 * grp + 14, nr = s_top / 4 + 1;
    const int lu = lane >> 4;
    const bf16* kl = KS + 128 * h + 8 * (lane & 15); const bf16* vl = VS + 128 * h + 8 * (lane & 15);
    const LAS unsigned char* rd = ring + 64 * c;
#define SB_ISSUE(r) do { int s_ = s_top - 4 * (r) - lu; s_ = s_ >= 0 ? s_ : 0; LAS unsigned char* sl_ = ring + ((r) % SB_NR) * 2048; \
        __builtin_amdgcn_global_load_lds((const unsigned*)(kl + (size_t)s_ * ZC), (LAS unsigned*)sl_, 16, 0, 0); \
        __builtin_amdgcn_global_load_lds((const unsigned*)(vl + (size_t)s_ * ZC), (LAS unsigned*)(sl_ + 1024), 16, 0, 0); } while (0)
#pragma unroll 1
    for (int r = 0; r < SB_PF; ++r) SB_ISSUE(r);
#pragma unroll 1
    for (int r = 0; r < nr; ++r) {
        SB_ISSUE(r + SB_PF);
        if constexpr (SB_PF == 6) asm volatile("s_waitcnt vmcnt(12)" ::: "memory"); else asm volatile("s_waitcnt vmcnt(6)" ::: "memory");
        static_assert(SB_PF == 6 || SB_PF == 3, "counted wait");
        const LAS unsigned char* sl = rd + (r % SB_NR) * 2048;
        const int s0 = s_top - 4 * r;
        float av[4];
#pragma unroll
        for (int u = 0; u < 4; ++u) { float z0 = 0.f, z1 = 0.f;
#pragma unroll
            for (int j = 0; j < 4; ++j) { const v4u kw = *(const LAS v4u*)(sl + 256 * u + 16 * j);
                z0 = dot2bf(kw.x, q[4 * j], z0); z1 = dot2bf(kw.y, q[4 * j + 1], z1); z0 = dot2bf(kw.z, q[4 * j + 2], z0); z1 = dot2bf(kw.w, q[4 * j + 3], z1); }
            const float z = grp_sum<4>(z0 + z1) * 0.08838834764831845f;
            const int s = s0 - u; const bool valid = s >= 0 && s < t;
            const float sp = valid ? softplus_f(z) : 0.f; R += sp; av[u] = valid ? __expf(z - R) : 0.f; }
#pragma unroll
        for (int u = 0; u < 4; ++u) {
            const unsigned alo = pk2(av[u], 0.f), ahi = alo << 16;
#pragma unroll
            for (int j = 0; j < 4; ++j) { const v4u vw = *(const LAS v4u*)(sl + 1024 + 256 * u + 16 * j);
                o[8 * j] = dot2bf(vw.x, alo, o[8 * j]); o[8 * j + 1] = dot2bf(vw.x, ahi, o[8 * j + 1]); o[8 * j + 2] = dot2bf(vw.y, alo, o[8 * j + 2]); o[8 * j + 3] = dot2bf(vw.y, ahi, o[8 * j + 3]);
                o[8 * j + 4] = dot2bf(vw.z, alo, o[8 * j + 4]); o[8 * j + 5] = dot2bf(vw.z, ahi, o[8 * j + 5]); o[8 * j + 6] = dot2bf(vw.w, alo, o[8 * j + 6]); o[8 * j + 7] = dot2bf(vw.w, ahi, o[8 * j + 7]); }
        }
        asm volatile("s_waitcnt lgkmcnt(0)" ::: "memory");
        if (__all(R > 44.f)) break;
    }
#undef SB_ISSUE
    asm volatile("s_waitcnt vmcnt(0)" ::: "memory");
    bf16* yp = Y + (size_t)t * 512 + co;
#pragma unroll
    for (int j = 0; j < 4; ++j) { v4u w; w.x = pk2(o[8 * j], o[8 * j + 1]); w.y = pk2(o[8 * j + 2], o[8 * j + 3]); w.z = pk2(o[8 * j + 4], o[8 * j + 5]); w.w = pk2(o[8 * j + 6], o[8 * j + 7]); *(v4u*)(yp + 8 * j) = w; }
}

typedef float f32x16 __attribute__((ext_vector_type(16)));
typedef short bf16x8 __attribute__((ext_vector_type(8)));
constexpr int ML_KSTR = 400, ML_VSTR = 144, ML_KB = 64 * ML_KSTR, ML_VB = 128 * ML_VSTR, ML_BUF = ML_KB + ML_VB;
DI int crow(int r, int hi) { return (r & 3) + 8 * (r >> 2) + 4 * hi; }
DI bf16x8 pack8(const f32x16& p, int b) { v4u w; w.x = pk2(p[b], p[b + 1]); w.y = pk2(p[b + 2], p[b + 3]); w.z = pk2(p[b + 4], p[b + 5]); w.w = pk2(p[b + 6], p[b + 7]); return __builtin_bit_cast(bf16x8, w); }
DI float half_swap_max(float v) { auto rr = __builtin_amdgcn_permlane32_swap(__float_as_uint(v), __float_as_uint(v), false, false); return fmaxf(__uint_as_float(rr[0]), __uint_as_float(rr[1])); }
DI float half_swap_sum(float v) { auto rr = __builtin_amdgcn_permlane32_swap(__float_as_uint(v), __float_as_uint(v), false, false); return __uint_as_float(rr[0]) + __uint_as_float(rr[1]); }
DI void mla_flash_unit(const bf16* __restrict__ QM, const bf16* __restrict__ KM, const bf16* __restrict__ VT, float* __restrict__ PO, float* __restrict__ ML, int h, int qb, int t_lo, int t_hi,
                       LAS unsigned char* lds, int tid) {
    const int lane = tid & 63, wave = __builtin_amdgcn_readfirstlane(tid >> 6), r32 = lane & 31, hi = lane >> 5;
    const int qw = qb * 256 + 32 * wave, qrow = qw + r32;
    bf16x8 qf[12];
    { const bf16* qp = QM + (size_t)qrow * 768 + 192 * h + 8 * hi;
#pragma unroll
      for (int ks = 0; ks < 12; ++ks) qf[ks] = *(const bf16x8*)(qp + 16 * ks); }
    asm volatile("s_waitcnt vmcnt(0)" ::: "memory");
#pragma unroll
    for (int ks = 0; ks < 12; ++ks) asm volatile("" : "+v"(qf[ks]));
    f32x16 o[4];
#pragma unroll
    for (int d = 0; d < 4; ++d)
#pragma unroll
        for (int r = 0; r < 16; ++r) o[d][r] = 0.f;
    float m = -1e30f, l = 0.f;
    const bf16* kbase = KM + 192 * h; const bf16* vbase = VT + (size_t)h * 128 * S;
    int krow[3], kch[3]; v4u sk[3], sv[2];
#pragma unroll
    for (int i = 0; i < 3; ++i) { const int id = tid + 512 * i; krow[i] = id / 24; kch[i] = id - 24 * krow[i]; }
    const int vd0 = tid >> 3, vc8 = tid & 7;
#define ML_LOAD(t) do { _Pragma("unroll") for (int i = 0; i < 3; ++i) sk[i] = *(const v4u*)(kbase + (size_t)(64 * (t) + krow[i]) * 768 + 8 * kch[i]); \
        _Pragma("unroll") for (int i = 0; i < 2; ++i) sv[i] = *(const v4u*)(vbase + (size_t)(vd0 + 64 * i) * S + 64 * (t) + 8 * vc8); } while (0)
#define ML_WRITE(b) do { LAS unsigned char* B_ = lds + (b) * ML_BUF; _Pragma("unroll") for (int i = 0; i < 3; ++i) *(LAS v4u*)(B_ + krow[i] * ML_KSTR + kch[i] * 16) = sk[i]; \
        _Pragma("unroll") for (int i = 0; i < 2; ++i) *(LAS v4u*)(B_ + ML_KB + (vd0 + 64 * i) * ML_VSTR + vc8 * 16) = sv[i]; } while (0)
#define ML_BAR() do { asm volatile("s_waitcnt lgkmcnt(0)" ::: "memory"); __builtin_amdgcn_s_barrier(); } while (0)
    const bool gB = wave >= 4;
    ML_LOAD(t_lo); ML_WRITE(t_lo & 1); __syncthreads();
    if (gB) { if (t_lo + 1 < t_hi) ML_LOAD(t_lo + 1); ML_BAR(); }
    for (int t = t_lo; t < t_hi; ++t) {
        const int k0 = 64 * t; const bool act = k0 <= qw + 31;
        f32x16 p0, p1;
        if (!gB && t + 1 < t_hi) ML_LOAD(t + 1);
        if (act) {
            const LAS unsigned char* Kb = lds + (t & 1) * ML_BUF + r32 * ML_KSTR + 16 * hi;
#pragma unroll
            for (int r = 0; r < 16; ++r) { p0[r] = 0.f; p1[r] = 0.f; }
            __builtin_amdgcn_s_setprio(1);
            {
                bf16x8 ka[3][2];
#pragma unroll
                for (int ks = 0; ks < 2; ++ks) { ka[ks][0] = *(const LAS bf16x8*)(Kb + 32 * ks); ka[ks][1] = *(const LAS bf16x8*)(Kb + 32 * ML_KSTR + 32 * ks); }
                __builtin_amdgcn_sched_barrier(0);
#pragma unroll
                for (int ks = 0; ks < 12; ++ks) {
                    if (ks + 2 < 12) { ka[(ks + 2) % 3][0] = *(const LAS bf16x8*)(Kb + 32 * (ks + 2)); ka[(ks + 2) % 3][1] = *(const LAS bf16x8*)(Kb + 32 * ML_KSTR + 32 * (ks + 2)); }
                    __builtin_amdgcn_sched_barrier(0);
                    p0 = __builtin_amdgcn_mfma_f32_32x32x16_bf16(ka[ks % 3][0], qf[ks], p0, 0, 0, 0);
                    p1 = __builtin_amdgcn_mfma_f32_32x32x16_bf16(ka[ks % 3][1], qf[ks], p1, 0, 0, 0);
                }
            }
            __builtin_amdgcn_s_setprio(0);
            if (k0 + 63 > qw) {
                const float NEG = -__builtin_inff();
#pragma unroll
                for (int r = 0; r < 16; ++r) { const int key = k0 + crow(r, hi); if (key > qrow) p0[r] = NEG; if (key + 32 > qrow) p1[r] = NEG; }
            }
        }
        if (gB && t + 1 < t_hi) ML_WRITE((t + 1) & 1);
        ML_BAR();
        if (gB && t + 2 < t_hi) ML_LOAD(t + 2);
        if (act) {
            const LAS unsigned char* Vb = lds + (t & 1) * ML_BUF + ML_KB + r32 * ML_VSTR + 16 * hi;
            float pmax = p0[0];
#pragma unroll
            for (int r = 1; r < 16; ++r) pmax = fmaxf(pmax, p0[r]);
#pragma unroll
            for (int r = 0; r < 16; ++r) pmax = fmaxf(pmax, p1[r]);
            pmax = half_swap_max(pmax);
            const float mn = fmaxf(m, pmax), alpha = __builtin_amdgcn_exp2f(m - mn);
            m = mn;
            float ps = 0.f;
#pragma unroll
            for (int r = 0; r < 16; ++r) { p0[r] = __builtin_amdgcn_exp2f(p0[r] - mn); p1[r] = __builtin_amdgcn_exp2f(p1[r] - mn); ps += p0[r] + p1[r]; }
            l = l * alpha + ps;
            if (!__all(alpha == 1.f)) {
#pragma unroll
                for (int d = 0; d < 4; ++d)
#pragma unroll
                    for (int r = 0; r < 16; ++r) o[d][r] *= alpha;
            }
            const bf16x8 pf0 = pack8(p0, 0), pf1 = pack8(p0, 8), pf2 = pack8(p1, 0), pf3 = pack8(p1, 8);
#pragma unroll
            for (int d = 0; d < 4; ++d) {
                const LAS unsigned char* vp = Vb + d * 32 * ML_VSTR;
                const bf16x8 v0 = *(const LAS bf16x8*)(vp), v1 = *(const LAS bf16x8*)(vp + 32), v2 = *(const LAS bf16x8*)(vp + 64), v3 = *(const LAS bf16x8*)(vp + 96);
                o[d] = __builtin_amdgcn_mfma_f32_32x32x16_bf16(v0, pf0, o[d], 0, 0, 0);
                o[d] = __builtin_amdgcn_mfma_f32_32x32x16_bf16(v1, pf1, o[d], 0, 0, 0);
                o[d] = __builtin_amdgcn_mfma_f32_32x32x16_bf16(v2, pf2, o[d], 0, 0, 0);
                o[d] = __builtin_amdgcn_mfma_f32_32x32x16_bf16(v3, pf3, o[d], 0, 0, 0);
            }
        }
        if (!gB && t + 1 < t_hi) ML_WRITE((t + 1) & 1);
        ML_BAR();
    }
    if (!gB) ML_BAR();
#undef ML_BAR
    const float lt = half_swap_sum(l);
    if (hi == 0) *(f32x2*)(ML + 2 * (32 * wave + r32)) = (f32x2){m, lt};
    float* yp = PO + (size_t)(32 * wave + r32) * 128 + 4 * hi;
#pragma unroll
    for (int d = 0; d < 4; ++d)
#pragma unroll
        for (int g = 0; g < 4; ++g) *(f32x4*)(yp + 32 * d + 8 * g) = (f32x4){o[d][4 * g], o[d][4 * g + 1], o[d][4 * g + 2], o[d][4 * g + 3]};
#undef ML_LOAD
#undef ML_WRITE
}

typedef short s16x4 __attribute__((ext_vector_type(4)));
constexpr int CU_P = 0, CU_M2 = 9216, CU_Q = 13824, CU_D2 = 22016, CU_BYTES = 26112;
constexpr int CL_RA = 0, CL_RB = 4608, CL_RK = 9216, CL_RR = 13824, CL_XA = 0, CL_XB = 5120, CL_XK = 10240, CL_XV = 15360, CL_T = 20480, CL_AAK = 24576, CL_ARB = 27136, CL_ARK = 29696, CL_WC = 32256, CL_BYTES = 32512;
DI unsigned short bf1(float x) { return (unsigned short)(pk2(x, 0.f) & 0xffffu); }
DI bf16x8 ld16(const LAS unsigned char* p) { return *(const LAS bf16x8*)p; }
DI bf16x8 ld8x2(const LAS unsigned char* p0, const LAS unsigned char* p1) { const s16x4 a = *(const LAS s16x4*)p0, b = *(const LAS s16x4*)p1; return __builtin_shufflevector(a, b, 0, 1, 2, 3, 4, 5, 6, 7); }
#define MFMA32(a, b, c) __builtin_amdgcn_mfma_f32_32x32x16_bf16((a), (b), (c), 0, 0, 0)
#define FR_RM(off, ks)        ld16(bR + (off) + 32 * (ks))
#define FR_X(off, rb, ks)     ld16(bX + (off) + (rb) * 80 + 32 * (ks))
#define FR_XP(off, rb, s)     ld8x2(bP + (off) + (rb) * 80 + 32 * (s), bP + (off) + (rb) * 80 + 32 * (s) + 16)
DI f32x16 zero16() { f32x16 z;
#pragma unroll
    for (int i = 0; i < 16; ++i) z[i] = 0.f;
    return z; }

DI void rwkv_chunk_unit(const unsigned* __restrict__ RKP, bf16* __restrict__ KP, const bf16* __restrict__ VB, const bf16* __restrict__ LOF,
                        const float* __restrict__ w0p, const float* __restrict__ a0p, const float* __restrict__ kkp, const float* __restrict__ kap,
                        unsigned char* __restrict__ CH, int u, LAS unsigned char* L, int lane_in) {
    int lane = lane_in; asm volatile("" : "+v"(lane));
    const int c = u >> 4, h = u & 15, l32 = lane & 31, hi = lane >> 5;
    unsigned char* rec = CH + (size_t)u * CU_BYTES;
    const LAS unsigned char* bR = L + l32 * 144 + 16 * hi; const LAS unsigned char* bX = L + l32 * 80 + 16 * hi; const LAS unsigned char* bP = L + l32 * 80 + 8 * hi; const LAS unsigned char* bU = L;
    LAS unsigned char* bW2 = L + 2 * lane; LAS unsigned char* bW80 = L + 80 * lane; LAS unsigned char* bS4 = L + 4 * l32 + 512 * hi; LAS unsigned char* bS2 = L + 2 * l32 + 320 * hi;
    asm volatile("" : "+v"(bR), "+v"(bX), "+v"(bP), "+v"(bU), "+v"(bW2), "+v"(bW80), "+v"(bS4), "+v"(bS2));
    v4u xa[4], xb[4], xk[4], xv[4];
    {
        const size_t g0 = (size_t)(32 * c) * 1024 + 64 * h + lane;
        const float w0c = w0p[64 * h + lane], a0c = a0p[64 * h + lane], kkc = kkp[64 * h + lane], kac = kap[64 * h + lane];
        float Lc = 0.f;
#pragma unroll
        for (int half = 0; half < 2; ++half) {
            unsigned rk_[16], vw_[16], wa_[16];
#pragma unroll
            for (int j = 0; j < 16; ++j) { const size_t off = g0 + (size_t)(16 * half + j) * 1024; const size_t lo = (size_t)(32 * c + 16 * half + j) * 3072 + 2 * (64 * h + lane);
                rk_[j] = RKP[off]; vw_[j] = *(const unsigned*)(VB + (off & ~(size_t)1)); wa_[j] = *(const unsigned*)(LOF + lo); }
            __builtin_amdgcn_sched_barrier(0);
#pragma unroll
            for (int tg2 = 0; tg2 < 2; ++tg2) {
                const int tg = 2 * half + tg2;
                float at[8], bt[8], kt[8];
#pragma unroll
                for (int j = 0; j < 8; ++j) {
                    const int t = 8 * tg + j, jj = 8 * tg2 + j;
                    const float lwl = -__expf(-softplus_f(-(w0c + bflo(wa_[jj]))) - 0.5f);
                    const float av_ = sigmoid_f(a0c + bfhi(wa_[jj]));
                    const float kraw = bfhi(rk_[jj]), kkr = kraw * kkc;
                    const float inv = 1.f / fmaxf(sqrtf(wave_sum(kkr * kkr)), 1e-12f);
                    const float kkn = kkr * inv, kpr = kraw * (1.f + (av_ - 1.f) * kac), bb = kkn * av_;
                    KP[g0 + (size_t)t * 1024] = bf1(kpr);
                    const float Lp = Lc; Lc += lwl;
                    const float e1 = __expf(Lc), e0 = __expf(Lp), ei = __expf(-Lc);
                    const float ra = bflo(rk_[jj]) * e1, aa = -kkn * e0, ba = bb * ei, ka = kpr * ei;
                    *(LAS unsigned short*)(bW2 + CL_RA + t * 144) = bf1(aa); *(LAS unsigned short*)(bW2 + CL_RB + t * 144) = bf1(ba);
                    *(LAS unsigned short*)(bW2 + CL_RK + t * 144) = bf1(ka); *(LAS unsigned short*)(bW2 + CL_RR + t * 144) = bf1(ra);
                    at[j] = aa; bt[j] = ba; kt[j] = ka;
                }
                v4u w;
                w.x = pk2(at[0], at[1]); w.y = pk2(at[2], at[3]); w.z = pk2(at[4], at[5]); w.w = pk2(at[6], at[7]); xa[tg] = w;
                w.x = pk2(bt[0], bt[1]); w.y = pk2(bt[2], bt[3]); w.z = pk2(bt[4], bt[5]); w.w = pk2(bt[6], bt[7]); xb[tg] = w;
                w.x = pk2(kt[0], kt[1]); w.y = pk2(kt[2], kt[3]); w.z = pk2(kt[4], kt[5]); w.w = pk2(kt[6], kt[7]); xk[tg] = w;
                { const unsigned sh = (lane & 1) ? 16u : 0u;
#define VSEL(i) ((vw_[8 * tg2 + (i)] >> sh) & 0xffffu)
                  w.x = VSEL(0) | (VSEL(1) << 16); w.y = VSEL(2) | (VSEL(3) << 16); w.z = VSEL(4) | (VSEL(5) << 16); w.w = VSEL(6) | (VSEL(7) << 16);
#undef VSEL
                }
                xv[tg] = w;
            }
            __builtin_amdgcn_sched_barrier(0);
        }
        *(LAS float*)(bW2 + 2 * lane + CL_WC) = __expf(Lc);
    }
    __builtin_amdgcn_sched_barrier(0);
    {
        f32x16 aab = zero16(), aak = zero16(), arb = zero16(), ark = zero16();
#pragma unroll
        for (int ks = 0; ks < 4; ++ks) {
            const bf16x8 fa = FR_RM(CL_RA, ks), fb = FR_RM(CL_RB, ks), fk = FR_RM(CL_RK, ks), fr = FR_RM(CL_RR, ks);
            aab = MFMA32(fa, fb, aab); aak = MFMA32(fa, fk, aak); arb = MFMA32(fr, fb, arb); ark = MFMA32(fr, fk, ark);
        }
#pragma unroll
        for (int r = 0; r < 16; ++r) {
            const int cr = (r & 3) + 8 * (r >> 2), t = cr + 4 * hi; const bool strict = t > l32, incl = t >= l32;
            *(LAS float*)(bS4 + CL_T + cr * 128) = strict ? aab[r] : 0.f;
            *(LAS unsigned short*)(bS2 + CL_AAK + cr * 80) = bf1(strict ? aak[r] : 0.f);
            *(LAS unsigned short*)(bS2 + CL_ARB + cr * 80) = bf1(incl ? arb[r] : 0.f);
            *(LAS unsigned short*)(bS2 + CL_ARK + cr * 80) = bf1(incl ? ark[r] : 0.f);
            __builtin_amdgcn_sched_barrier(0);
        }
    }
    s16x4 rinit[2][4];
#pragma unroll
    for (int mt = 0; mt < 2; ++mt)
#pragma unroll
        for (int g = 0; g < 4; ++g) rinit[mt][g] = *(const LAS s16x4*)(bR - 8 * hi + CL_RR + 2 * (32 * mt + 8 * g));
    __builtin_amdgcn_sched_barrier(0);
#pragma unroll
    for (int tg = 0; tg < 4; ++tg) { *(LAS v4u*)(bW80 + CL_XA + 16 * tg) = xa[tg]; *(LAS v4u*)(bW80 + CL_XB + 16 * tg) = xb[tg]; *(LAS v4u*)(bW80 + CL_XK + 16 * tg) = xk[tg]; *(LAS v4u*)(bW80 + CL_XV + 16 * tg) = xv[tg]; }
    __builtin_amdgcn_sched_barrier(0);
    {
        float x[32];
        const LAS unsigned char* bE = bU; const LAS unsigned char* bO = bU;
#pragma unroll
        for (int t = 0; t < 32; ++t) {
            float acc = (t == l32) ? 1.f : 0.f;
            const LAS unsigned char* bT = (t & 1) ? bO : bE;
#pragma unroll
            for (int q = 0; q < (t + 3) / 4; ++q) {
                const f32x4 a4 = *(const LAS f32x4*)(bT + CL_T + t * 128 + 16 * q);
#pragma unroll
                for (int e = 0; e < 4; ++e) if (4 * q + e < t) acc = fmaf(a4[e], x[4 * q + e], acc);
            }
            if (t & 1) asm volatile("" : "+v"(acc), "+v"(bO)); else asm volatile("" : "+v"(acc), "+v"(bE));
            x[t] = acc;
        }
#pragma unroll
        for (int t = 0; t < 32; ++t) *(LAS unsigned short*)(bS2 - 320 * hi + CL_T + t * 80) = bf1(x[t]);
    }
    __builtin_amdgcn_sched_barrier(0);
    f32x16 m1[2], d1[2];
#pragma unroll
    for (int nt = 0; nt < 2; ++nt) { m1[nt] = zero16();
#pragma unroll
        for (int ks = 0; ks < 2; ++ks) m1[nt] = MFMA32(FR_X(CL_T, 0, ks), FR_X(CL_XA, 32 * nt, ks), m1[nt]); }
    __builtin_amdgcn_sched_barrier(0);
#pragma unroll
    for (int nt = 0; nt < 2; ++nt) { f32x16 g = zero16();
#pragma unroll
        for (int ks = 0; ks < 2; ++ks) g = MFMA32(FR_X(CL_AAK, 0, ks), FR_X(CL_XV, 32 * nt, ks), g);
        d1[nt] = zero16();
        d1[nt] = MFMA32(FR_XP(CL_T, 0, 0), pack8(g, 0), d1[nt]); d1[nt] = MFMA32(FR_XP(CL_T, 0, 1), pack8(g, 8), d1[nt]); }
    __builtin_amdgcn_sched_barrier(0);
#pragma unroll
    for (int mt = 0; mt < 2; ++mt) {
        f32x16 z;
#pragma unroll
        for (int g = 0; g < 4; ++g) { const s16x4 rv = rinit[mt][g];
#pragma unroll
            for (int b = 0; b < 4; ++b) z[4 * g + b] = bf2f((unsigned)(unsigned short)rv[b]); }
        z = MFMA32(pack8(m1[mt], 0), FR_XP(CL_ARB, 0, 0), z); z = MFMA32(pack8(m1[mt], 8), FR_XP(CL_ARB, 0, 1), z);
#pragma unroll
        for (int g = 0; g < 4; ++g) { v2u w; w.x = pk2(z[4 * g], z[4 * g + 1]); w.y = pk2(z[4 * g + 2], z[4 * g + 3]);
            *(v2u*)(rec + CU_M2 + l32 * 144 + 2 * (16 * (2 * mt + (g >> 1)) + 8 * hi + 4 * (g & 1))) = w; }
        __builtin_amdgcn_sched_barrier(0);
    }
    __builtin_amdgcn_sched_barrier(0);
#pragma unroll
    for (int nt = 0; nt < 2; ++nt) {
        f32x16 z = zero16();
        z = MFMA32(FR_XP(CL_ARB, 0, 0), pack8(d1[nt], 0), z); z = MFMA32(FR_XP(CL_ARB, 0, 1), pack8(d1[nt], 8), z);
#pragma unroll
        for (int ks = 0; ks < 2; ++ks) z = MFMA32(FR_X(CL_ARK, 0, ks), FR_X(CL_XV, 32 * nt, ks), z);
#pragma unroll
        for (int g = 0; g < 4; ++g) { v2u w; w.x = pk2(z[4 * g], z[4 * g + 1]); w.y = pk2(z[4 * g + 2], z[4 * g + 3]); *(v2u*)(rec + CU_D2 + ((((nt * 4 + g) * 2 + hi) * 32 + l32) << 3)) = w; }
        __builtin_amdgcn_sched_barrier(0);
    }
    __builtin_amdgcn_sched_barrier(0);
#pragma unroll
    for (int nk = 0; nk < 2; ++nk) {
        const float wck = *(const LAS float*)(bS4 - 512 * hi + CL_WC + 128 * nk);
#pragma unroll
        for (int mt = 0; mt < 2; ++mt) {
            f32x16 z = zero16();
            z = MFMA32(pack8(m1[mt], 0), FR_XP(CL_XB, 32 * nk, 0), z); z = MFMA32(pack8(m1[mt], 8), FR_XP(CL_XB, 32 * nk, 1), z);
#pragma unroll
            for (int g = 0; g < 4; ++g) { float pv[4];
#pragma unroll
                for (int b = 0; b < 4; ++b) { const int k2 = 32 * mt + 8 * g + 4 * hi + b; pv[b] = (z[4 * g + b] + ((k2 == 32 * nk + l32) ? 1.f : 0.f)) * wck; }
                v2u w; w.x = pk2(pv[0], pv[1]); w.y = pk2(pv[2], pv[3]);
                *(v2u*)(rec + CU_P + (32 * nk + l32) * 144 + 2 * (16 * (2 * mt + (g >> 1)) + 8 * hi + 4 * (g & 1))) = w; }
            __builtin_amdgcn_sched_barrier(0);
        }
    }
    __builtin_amdgcn_sched_barrier(0);
#pragma unroll
    for (int nt = 0; nt < 2; ++nt)
#pragma unroll
        for (int mt = 0; mt < 2; ++mt) {
            f32x16 z = zero16();
            z = MFMA32(FR_XP(CL_XB, 32 * mt, 0), pack8(d1[nt], 0), z); z = MFMA32(FR_XP(CL_XB, 32 * mt, 1), pack8(d1[nt], 8), z);
#pragma unroll
            for (int ks = 0; ks < 2; ++ks) z = MFMA32(FR_X(CL_XK, 32 * mt, ks), FR_X(CL_XV, 32 * nt, ks), z);
#pragma unroll
            for (int g = 0; g < 4; ++g) { const f32x4 wc4 = *(const LAS f32x4*)(bP - 80 * l32 + 8 * hi + CL_WC + 4 * (32 * mt + 8 * g));
                v2u w; w.x = pk2(z[4 * g] * wc4[0], z[4 * g + 1] * wc4[1]); w.y = pk2(z[4 * g + 2] * wc4[2], z[4 * g + 3] * wc4[3]); *(v2u*)(rec + CU_Q + ((((((nt * 2 + mt) * 4 + g) * 2 + hi) * 32 + l32)) << 3)) = w; }
            __builtin_amdgcn_sched_barrier(0);
        }
}

constexpr int SQ_SLOT = 20480, SQ_NSLOT = 4, SQ_XOFF = SQ_SLOT * SQ_NSLOT, SQ_XBUF = 4096;
DI void rwkv_seq_wg(const unsigned char* __restrict__ CH, bf16* __restrict__ Y, int h, int vs, LAS unsigned char* lds, int tid) {
    const int lane = tid & 63, wave = __builtin_amdgcn_readfirstlane(tid >> 6), l32 = lane & 31, hi = lane >> 5;
    constexpr int NCH = S / 32;
    { unsigned zz = 0u; asm volatile("" : "+v"(zz));
      for (int i = tid; i < 2 * SQ_XBUF / 16; i += 512) *(LAS v4u*)(lds + SQ_XOFF + 16 * i) = (v4u){zz, zz, zz, zz}; }
    __syncthreads();
    if (wave >= 3) {
        const int lw = wave - 3;
        for (int c = 0; c < NCH + 3; ++c) {
            if (c < NCH) {
                const unsigned char* rec = CH + (size_t)(c * 16 + h) * CU_BYTES;
#pragma unroll
                for (int i = 0; i < 4; ++i) {
                    const int pc = lw + 5 * i;
                    const int ob = pc * 1024 + lane * 16;
                    const unsigned char* src = ob < 13824 ? rec + ob : (ob < 17920 ? rec + CU_Q + vs * 4096 + (ob - 13824) : rec + CU_D2 + vs * 2048 + (ob - 17920));
                    if (ob >= 19968) src = rec;
                    __builtin_amdgcn_global_load_lds((const unsigned*)src, (LAS unsigned*)(lds + (c & 3) * SQ_SLOT + pc * 1024), 16, 0, 0);
                }
            }
            if (c < NCH) asm volatile("s_waitcnt vmcnt(8)" ::: "memory"); else asm volatile("s_waitcnt vmcnt(0)" ::: "memory");
            __builtin_amdgcn_s_barrier();
        }
    } else {
        for (int c = 0; c < NCH + 3; ++c) {
            if (c >= 3) {
                const int cc = c - 3;
                const LAS unsigned char* B = lds + (cc & 3) * SQ_SLOT;
                const LAS unsigned char* X = lds + SQ_XOFF + (cc & 1) * SQ_XBUF + lane * 16;
                const bf16x8 sb0 = ld16(X), sb1 = ld16(X + 1024), sb2 = ld16(X + 2048), sb3 = ld16(X + 3072);
                const LAS unsigned char* Am = B + (wave == 2 ? 9216 : wave * 32 * 144) + l32 * 144 + 16 * hi;
                const LAS unsigned char* Ci = B + (wave == 2 ? 17920 : 13824 + wave * 2048) + ((hi * 32 + l32) << 3);
                f32x16 n;
#pragma unroll
                for (int g = 0; g < 4; ++g) { const v2u q = *(const LAS v2u*)(Ci + g * 512);
                    n[4 * g] = bflo(q.x); n[4 * g + 1] = bfhi(q.x); n[4 * g + 2] = bflo(q.y); n[4 * g + 3] = bfhi(q.y); }
                n = MFMA32(ld16(Am), sb0, n); n = MFMA32(ld16(Am + 32), sb1, n); n = MFMA32(ld16(Am + 64), sb2, n); n = MFMA32(ld16(Am + 96), sb3, n);
                if (wave == 2) {
                    bf16* yp = Y + (size_t)(32 * cc) * 1024 + 64 * h + 32 * vs + l32;
#pragma unroll
                    for (int r = 0; r < 16; ++r) yp[(size_t)crow(r, hi) * 1024] = bf1(n[r]);
                } else {
                    LAS unsigned char* Xn = lds + SQ_XOFF + ((cc + 1) & 1) * SQ_XBUF + (2 * wave) * 1024 + lane * 16;
                    *(LAS bf16x8*)Xn = pack8(n, 0); *(LAS bf16x8*)(Xn + 1024) = pack8(n, 8);
                }
            }
            asm volatile("s_waitcnt lgkmcnt(0)" ::: "memory");
            __builtin_amdgcn_s_barrier();
        }
    }
}

constexpr int MQ_RW = 32, MQ_FULL = 160, MQ_HALF = 64, MQ_LAST = 128, MQ_TOTAL = MQ_RW + MQ_FULL + MQ_HALF + MQ_LAST;
DI void mixers_phase(const KA& a, int l, int tid, LAS unsigned char* lds, int rep = 0) {
    unsigned char* ws = a.ws();
    unsigned* head = (unsigned*)(ws + WS_CTL) + CW_QUEUE + 64 * l + 1024 * rep;
    volatile LAS unsigned* slot = (volatile LAS unsigned*)(lds + MISC_OFF + 64);
    const int wave_s = __builtin_amdgcn_readfirstlane(tid >> 6);
    for (;;) {
        if (fresh_tid(wave_s) == 0) *slot = __hip_atomic_fetch_add(head, 1u, __ATOMIC_RELAXED, __HIP_MEMORY_SCOPE_AGENT);
        __syncthreads();
        const int it = (int)*slot;
        __syncthreads();
        if (it >= MQ_TOTAL) break;
        if (it < MQ_RW) {
            rwkv_seq_wg(ws + WS_CHK, (bf16*)(ws + WS_YRW), it >> 1, it & 1, lds, fresh_tid(wave_s));
        } else {
            int h, qb, j, t_lo, t_hi, i = it - MQ_RW;
            if (i < MQ_FULL) { h = i / 40; int r = i - 40 * h;
                if (r < 16) { qb = 16 + (r >> 1); j = r & 1; } else { r -= 16; qb = 24 + r / 3; j = r - 3 * (r / 3); }
                t_lo = 32 * j; t_hi = t_lo + 32; }
            else if (i < MQ_FULL + 64 || i >= MQ_FULL + 64 + MQ_HALF) { i -= MQ_FULL; if (i >= 64) i -= MQ_HALF;
                const int k = i >> 4, w = i & 15; h = w & 3; const int gq = w >> 2; qb = 8 * gq + 7 - k; j = gq == 1 ? 2 : gq;
                t_lo = 32 * gq; const int t_end = 4 * (qb + 1); t_hi = t_lo + 32 < t_end ? t_lo + 32 : t_end; }
            else { i -= MQ_FULL + 64; h = i >> 4; const int r = i & 15; qb = 8 + (r >> 1); j = r & 1; t_lo = 16 * j; t_hi = t_lo + 16; }
            const int ps = (h * 32 + qb) * 4 + j;
            mla_flash_unit((const bf16*)(ws + WS_QM), (const bf16*)(ws + WS_KM), (const bf16*)(ws + WS_VT), (float*)(ws + WS_PO) + (size_t)ps * 256 * 128, (float*)(ws + WS_PML) + (size_t)ps * 512,
                           h, qb, t_lo, t_hi, lds, fresh_tid(wave_s));
        }
        __syncthreads();
    }
}

DI void post_phase(const KA& a, int l, int gw, int ngw, int lane) {
    unsigned char* ws = a.ws();
    const bf16* YSB = (const bf16*)(ws + WS_YSB); const bf16* YRW = (const bf16*)(ws + WS_YRW);
    const unsigned* RKP = (const unsigned*)(ws + WS_RR); const bf16* RK = (const bf16*)(ws + WS_RW); const bf16* VB = (const bf16*)(ws + WS_RV); const bf16* LOFG = (const bf16*)(ws + WS_LOF) + 2048;
    bf16* CAT = (bf16*)(ws + WS_CAT);
    const float* sbn = a.in(I_SBN) + l * 512; const float* mlan = a.in(I_MLAN) + l * 512; const float* lnw = a.in(I_LNW) + l * 1024; const float* lnb = a.in(I_LNB) + l * 1024; const float* rk = a.in(I_RK) + l * 1024;
    for (int t = gw; t < S; t += ngw) {
        bf16* cat = CAT + (size_t)t * D;
#pragma unroll
        for (int part = 0; part < 2; ++part) {
            f32x4 y0, y1;
            if (part == 0) { const v4u w = *(const v4u*)(YSB + (size_t)t * 512 + 8 * lane); y0 = (f32x4){bflo(w.x), bfhi(w.x), bflo(w.y), bfhi(w.y)}; y1 = (f32x4){bflo(w.z), bfhi(w.z), bflo(w.w), bfhi(w.w)}; }
            else {
                const int hh = lane >> 4, qb = t >> 8, nch = (qb >> 3) == 1 ? 3 : (qb >> 3) + 1, ps0 = (hh * 32 + qb) * 4, rl = t & 255;
                const float* PO = (const float*)(ws + WS_PO); const float* PML = (const float*)(ws + WS_PML);
                float mj[4], lj[4], M = -1e30f;
#pragma unroll
                for (int j = 0; j < 4; ++j) { mj[j] = -1e30f; lj[j] = 0.f; if (j < nch) { const f32x2 v = *(const f32x2*)(PML + (size_t)(ps0 + j) * 512 + 2 * rl); mj[j] = v.x; lj[j] = v.y; M = fmaxf(M, v.x); } }
                float Ls = 0.f; y0 = (f32x4){0.f, 0.f, 0.f, 0.f}; y1 = y0;
#pragma unroll
                for (int j = 0; j < 4; ++j) if (j < nch) { const float wj = __builtin_amdgcn_exp2f(mj[j] - M); Ls += lj[j] * wj;
                    const float* po = PO + ((size_t)(ps0 + j) * 256 + rl) * 128 + 8 * (lane & 15); y0 = y0 + *(const f32x4*)po * wj; y1 = y1 + *(const f32x4*)(po + 4) * wj; }
                const float il = 1.f / Ls; y0 = y0 * il; y1 = y1 * il;
            }
            const float* g = (part ? mlan : sbn) + 8 * lane;
            const f32x4 g0 = *(const f32x4*)g, g1 = *(const f32x4*)(g + 4);
            float s = (y0.x * y0.x + y0.y * y0.y) + (y0.z * y0.z + y0.w * y0.w) + (y1.x * y1.x + y1.y * y1.y) + (y1.z * y1.z + y1.w * y1.w);
            s = grp_sum<16>(s);
            const float rstd = 1.f / sqrtf(s * (1.f / 128.f) + EPS);
            v4u w; w.x = pk2(y0.x * rstd * g0.x, y0.y * rstd * g0.y); w.y = pk2(y0.z * rstd * g0.z, y0.w * rstd * g0.w); w.z = pk2(y1.x * rstd * g1.x, y1.y * rstd * g1.y); w.w = pk2(y1.z * rstd * g1.z, y1.w * rstd * g1.w);
            *(v4u*)(cat + 512 * part + 8 * lane) = w;
        }
        const size_t ro = (size_t)t * 1024 + 16 * lane;
        float y[16], sum = 0.f, bon = 0.f;
#pragma unroll
        for (int j = 0; j < 4; ++j) { const f32x4 yy = ldz4(YRW + ro + 4 * j), k4 = ldz4(RK + ro + 4 * j), rk4 = *(const f32x4*)(rk + 16 * lane + 4 * j);
            const v4u rp = *(const v4u*)(RKP + ro + 4 * j); const f32x4 r4 = {bflo(rp.x), bflo(rp.y), bflo(rp.z), bflo(rp.w)};
#pragma unroll
            for (int e = 0; e < 4; ++e) { y[4 * j + e] = yy[e]; sum += yy[e]; bon += r4[e] * k4[e] * rk4[e]; } }
        sum = grp_sum<4>(sum); bon = grp_sum<4>(bon);
        const float mean = sum * (1.f / 64.f); float var = 0.f;
#pragma unroll
        for (int i = 0; i < 16; ++i) { y[i] -= mean; var += y[i] * y[i]; }
        var = grp_sum<4>(var) * (1.f / 64.f);
        const float rstd = 1.f / sqrtf(var + 64e-5f);
#pragma unroll
        for (int j = 0; j < 2; ++j) {
            float ov[8];
            const v4u gp = *(const v4u*)(LOFG + (size_t)t * 3072 + 16 * lane + 8 * j); const float gt[8] = {bflo(gp.x), bfhi(gp.x), bflo(gp.y), bfhi(gp.y), bflo(gp.z), bfhi(gp.z), bflo(gp.w), bfhi(gp.w)};
            const v4u vp = *(const v4u*)(VB + ro + 8 * j); const float vt[8] = {bflo(vp.x), bfhi(vp.x), bflo(vp.y), bfhi(vp.y), bflo(vp.z), bfhi(vp.z), bflo(vp.w), bfhi(vp.w)};
#pragma unroll
            for (int e = 0; e < 8; ++e) { const int i = 8 * j + e, c = 16 * lane + i;
                ov[e] = (y[i] * rstd * lnw[c] + lnb[c] + bon * vt[e]) * gt[e];
            }
            v4u w; w.x = pk2(ov[0], ov[1]); w.y = pk2(ov[2], ov[3]); w.z = pk2(ov[4], ov[5]); w.w = pk2(ov[6], ov[7]);
            *(v4u*)(cat + 1024 + 16 * lane + 8 * j) = w;
        }
    }
}

constexpr int N_PHASES = NL * (1 + 2 + 7 + 2) + 1;
__global__ void __launch_bounds__(NWAVES * 64, 2) hybrid_fwd(Args args) {
    extern __shared__ __attribute__((aligned(16))) unsigned char lds_raw[];
    LAS unsigned char* lds = (LAS unsigned char*)lds_raw;
    const int tid = threadIdx.x;
    const int G_k = gridDim.x, bid_k = blockIdx.x, wave_k = __builtin_amdgcn_readfirstlane(tid >> 6);
    volatile LAS unsigned* MISC = (volatile LAS unsigned*)(lds + MISC_OFF);
#if MK_SINGLE
    for (int u = tid; u < (LDS_BYTES - MISC_OFF) / 4; u += NWAVES * 64) ((LAS unsigned*)(lds + MISC_OFF))[u] = 0u;
    __syncthreads();
    XcdBarrier bar = xcd_barrier_post((unsigned*)(args.ws + WS_CTL) + CW_BAR, MISC + 8);
#define GRID_BAR() xcd_barrier(bar, fresh_tid(wave_p))
#else
#define GRID_BAR() do {} while (0)
#endif
    const int lo = args.ph_lo, hi = args.ph_hi;
    int ph = 0;
#define PHASE_BEGIN if (ph >= lo && ph < hi) { int wave_p = wave_k; asm volatile("" : "+s"(wave_p)); int lane_p; \
        asm volatile("v_mbcnt_lo_u32_b32 %0, -1, 0\n\tv_mbcnt_hi_u32_b32 %0, -1, %0" : "=v"(lane_p)); const int tid_p = (wave_p << 6) | lane_p; \
        kaptr_t ka_p = (kaptr_t)__builtin_amdgcn_kernarg_segment_ptr(); asm volatile("" : "+s"(ka_p)); const KA a{ka_p}; unsigned char* ws = a.ws(); \
        int G = G_k, bid = bid_k; asm volatile("" : "+s"(G), "+s"(bid)); const int ngw = G * NWAVES; (void)ngw; \
        const int lane = lane_p, wave = wave_p, gw = bid * NWAVES + wave, wi = wave * G + bid; (void)lane; (void)gw; (void)wi; (void)ws;
#define PHASE_END   if (ph + 1 < hi) GRID_BAR(); } ++ph;

#pragma unroll
    for (int l = 0; l < NL; ++l) {
        const size_t WB = (l & 1) ? WB_DELTA : 0;
        PHASE_BEGIN if (l == 0) { conv_phase(a, 0, lds, gw, ngw, wave, lane); __syncthreads(); } else conv_harvest(a, l, -1, G, tid_p, lds);
        PHASE_END
#pragma unroll
        for (int f = 0; f < 2; ++f) {
            PHASE_BEGIN {
                pg8::Gemm g{(const pg8::bf16_t*)(ws + WS_XB), (const pg8::bf16_t*)(ws + WB + (f ? W_GU1 : W_GU0)), S, 2 * FF, D}; pg8::StaticOrder So; So.init(S, 2 * FF, G, bid);
                rstd_table(So, (const float*)(ws + WS_PART), (LAS _Float16*)(lds + RING_BYTES + 8192), fresh_tid(wave_p));
                pg8::EpiSwiglu E{(pg8::bf16_t*)(ws + WS_H), FF, (const LAS _Float16*)(lds + RING_BYTES + 8192)};
                pg8::gemm_phase<pg8::EpiSwiglu, pg8::StaticOrder, true, true>(lds, g, So, E, fresh_tid(wave_p));
                if (l + 1 < NL) conv_harvest(a, l + 1, ph, G, fresh_tid(wave_p), lds); } PHASE_END
            PHASE_BEGIN {
                pg8::Gemm g{(const pg8::bf16_t*)(ws + WS_H), (const pg8::bf16_t*)(ws + WB + (f ? W_DN1 : W_DN0)), S, D, FF}; pg8::StaticOrder So; So.init(S, D, G, bid);
                pg8::EpiResid E{(pg8::bf16_t*)(ws + WS_XB), D, 0.5f, (float*)(ws + WS_PART), (LAS float*)(lds + RING_BYTES + 1024)};
                pg8::gemm_phase<pg8::EpiResid, pg8::StaticOrder, true, true>(lds, g, So, E, fresh_tid(wave_p)); } PHASE_END
            if (f == 0) {
                PHASE_BEGIN {
                    pg8::Gemm g{(const pg8::bf16_t*)(ws + WS_XB), (const pg8::bf16_t*)(ws + WB + W_IN), S, ZC, D}; pg8::StaticOrder So; So.init(S, ZC, G, bid);
                    rstd_table(So, (const float*)(ws + WS_PART), (LAS _Float16*)(lds + RING_BYTES + 8192), fresh_tid(wave_p));
                    pg8::EpiBf16 E{(pg8::bf16_t*)(ws + WS_Z), ZC, (const LAS _Float16*)(lds + RING_BYTES + 8192)};
                    pg8::gemm_phase<pg8::EpiBf16, pg8::StaticOrder, true, true>(lds, g, So, E, fresh_tid(wave_p));
                    if (l + 1 < NL) conv_harvest(a, l + 1, ph, G, fresh_tid(wave_p), lds); } PHASE_END
                PHASE_BEGIN prep1_phase(a, l, gw, ngw, lane);
                PHASE_END
                PHASE_BEGIN {
                    { pg8::Gemm g{(const pg8::bf16_t*)(ws + WS_CQN), (const pg8::bf16_t*)(ws + WB + W_UQ), S, 768, 512}; pg8::StaticOrder So; So.init(S, 768, G, bid);
                      pg8::EpiQM E{ws};
                      pg8::gemm_phase<pg8::EpiQM, pg8::StaticOrder, true, true>(lds, g, So, E, fresh_tid(wave_p)); }
                    { pg8::Gemm g{(const pg8::bf16_t*)(ws + WS_CKVN), (const pg8::bf16_t*)(ws + WB + W_UKV), S, 512, 256}; pg8::StaticOrder So; So.init(S, 512, G, (bid + G - 96 % G) % G);
                      pg8::EpiKM E{ws}; pg8::gemm_phase<pg8::EpiKM, pg8::StaticOrder, true, true>(lds, g, So, E, fresh_tid(wave_p)); }
                    { pg8::Gemm g{(const pg8::bf16_t*)(ws + WB + W_UKVV), (const pg8::bf16_t*)(ws + WS_CKVN), 512, S, 256}; pg8::StaticOrder So; So.init(512, S, G, (bid + G - 160 % G) % G);
                      pg8::EpiVT E{(pg8::bf16_t*)(ws + WS_VT), S}; pg8::gemm_phase<pg8::EpiVT, pg8::StaticOrder, true, true>(lds, g, So, E, fresh_tid(wave_p)); }
                    { pg8::Gemm g{(const pg8::bf16_t*)(ws + WS_LORAA), (const pg8::bf16_t*)(ws + WB + W_LORA), S, 3072, 256}; pg8::StaticOrder So; So.init(S, 3072, G, (bid + G - 96 % G) % G);
                      pg8::EpiBf16 E{(pg8::bf16_t*)(ws + WS_LOF), 3072, nullptr}; pg8::gemm_phase<pg8::EpiBf16, pg8::StaticOrder, true, true>(lds, g, So, E, fresh_tid(wave_p)); }
                    if (l + 1 < NL) conv_harvest(a, l + 1, ph, G, fresh_tid(wave_p), lds); } PHASE_END
                PHASE_BEGIN {
                    if (wave < 4) { for (int u = bid * 4 + wave; u < 4096; u += G * 4)
                        rwkv_chunk_unit((const unsigned*)(ws + WS_RR), (bf16*)(ws + WS_RW), (const bf16*)(ws + WS_RV), (const bf16*)(ws + WS_LOF),
                                        a.in(I_W0) + l * 1024, a.in(I_A0) + l * 1024, a.in(I_KK) + l * 1024, a.in(I_KA) + l * 1024, ws + WS_CHK, u, lds + wave * CL_BYTES, lane); }
                    else { prep2_phase(a, l, bid * 4 + (wave - 4), G * 4, lane);
                        for (int u0 = bid * 4 + (wave - 4); u0 < 1024; u0 += G * 4) {
#pragma unroll 1
                            for (int r2 = 0; r2 < 2; ++r2) { const int sbi = r2 ? 2047 - u0 : u0;
                                sb_item<3, 4>((const bf16*)(ws + WS_Z) + ZC_SBQ, (const bf16*)(ws + WS_Z) + ZC_SBK, (const bf16*)(ws + WS_Z) + ZC_SBV, (bf16*)(ws + WS_YSB), sbi >> 9, sbi & 511, lane,
                                              lds + 4 * CL_BYTES + (wave - 4) * 8192); } } } } PHASE_END
                PHASE_BEGIN mixers_phase(a, l, tid_p, lds); if (l + 1 < NL) conv_harvest(a, l + 1, ph, G, fresh_tid(wave_p), lds);
                PHASE_END
                PHASE_BEGIN post_phase(a, l, gw, ngw, lane);
                PHASE_END
                PHASE_BEGIN {
                    pg8::Gemm g{(const pg8::bf16_t*)(ws + WS_CAT), (const pg8::bf16_t*)(ws + WB + W_OUT), S, D, D}; pg8::StaticOrder So; So.init(S, D, G, bid);
                    pg8::EpiResid E{(pg8::bf16_t*)(ws + WS_XB), D, 1.0f, (float*)(ws + WS_PART), (LAS float*)(lds + RING_BYTES + 1024)};
                    pg8::gemm_phase<pg8::EpiResid, pg8::StaticOrder, true, true>(lds, g, So, E, fresh_tid(wave_p)); } PHASE_END
            }
        }
    }
    PHASE_BEGIN final_phase((const bf16*)(ws + WS_XB), a.out(), a.in(I_FN), gw, ngw, lane); PHASE_END
}

extern "C" void kernel_launch(void* const* d_in, const int* in_sizes, int n_in, void* d_out, int out_size, void* d_ws, size_t ws_size, hipStream_t stream) {
    static int grid = 0;
    if (grid == 0) {
        if (n_in != N_IN || in_sizes[0] != S * D || out_size != S * D || ws_size < WS_END) {
            fprintf(stderr, "kernel_launch: shape/workspace mismatch (n_in %d, in0 %d, out %d, ws %zu, need %zu); nothing launched\n", n_in, n_in > 0 ? in_sizes[0] : -1, out_size, ws_size, (size_t)WS_END); grid = -1; return; }
        int dev = 0, cus = 0, per_cu = 0;
        if (hipGetDevice(&dev) != hipSuccess || hipDeviceGetAttribute(&cus, hipDeviceAttributeMultiprocessorCount, dev) != hipSuccess) { grid = -1; return; }
        if (hipFuncSetAttribute((const void*)hybrid_fwd, hipFuncAttributeMaxDynamicSharedMemorySize, LDS_BYTES) != hipSuccess) { fprintf(stderr, "kernel_launch: hipFuncSetAttribute failed\n"); grid = -1; return; }
        if (hipOccupancyMaxActiveBlocksPerMultiprocessor(&per_cu, (const void*)hybrid_fwd, NWAVES * 64, LDS_BYTES) != hipSuccess || per_cu < 1)
            fprintf(stderr, "kernel_launch: note: occupancy query reports %d workgroups per CU\n", per_cu);
        (void)hipGetLastError();
        grid = cus;
    }
    if (grid < 0) return;
    (void)hipMemsetAsync((char*)d_ws + WS_CTL, 0, CTL_ZERO_BYTES, stream);
    Args a{};
    for (int i = 0; i < N_IN; ++i) a.in[i] = (const float*)d_in[i];
    a.out = (float*)d_out; a.ws = (unsigned char*)d_ws;
#if MK_SINGLE
    a.ph_lo = 0; a.ph_hi = N_PHASES;
    hipLaunchKernelGGL(hybrid_fwd, dim3(grid), dim3(NWAVES * 64), LDS_BYTES, stream, a);
#else
    for (int p = 0; p < N_PHASES; ++p) { a.ph_lo = p; a.ph_hi = p + 1; hipLaunchKernelGGL(hybrid_fwd, dim3(grid), dim3(NWAVES * 64), LDS_BYTES, stream, a); }
#endif
}
```
